# Optimizing an MI355X kernel written in HIP

```python
import jax, jax.numpy as jnp
from jax import lax
import numpy as np

D_MODEL = 1024
BATCH = 2
SEQ = 8192
DEPTH = 4

D_MIX = D_MODEL
GLA_HEADS = 4
GLA_DV = D_MIX // 2 // GLA_HEADS
GLA_DK = GLA_DV // 2
GLA_RANK = 16
GLA_GATE_NORM = 16.0
HG_HEADS = 4
HG_DK = 128
HG_DV = D_MIX // 2 // HG_HEADS
CHUNK = 64
D_FF_DENSE = 2816
N_EXPERTS = 8
TOP_K = 2
D_FF_EXPERT = 3584
PLE_DIM = 256
EPS = 1e-6
HEAD_EPS = 1e-5
F_MIN = 1e-6

GLA_QK = GLA_HEADS * GLA_DK
GLA_V = GLA_HEADS * GLA_DV
HG_K = HG_HEADS * HG_DK
HG_V = HG_HEADS * HG_DV
IN_SPLIT_SIZES = (GLA_QK, GLA_QK, GLA_V, GLA_V, GLA_RANK, GLA_RANK,
                  HG_K, HG_K, HG_K, HG_V, HG_V)
D_IN_PROJ = sum(IN_SPLIT_SIZES)

kernel_name = "hybrid_gla_hgrn2_moe_bidir_encoder"


def rmsnorm(x, w, eps=EPS):
    xf = x.astype(jnp.float32)
    y = xf * lax.rsqrt(jnp.mean(xf * xf, axis=-1, keepdims=True) + eps)
    return (y * w.astype(jnp.float32)).astype(x.dtype)


def to_heads(a, n_heads):
    b, s, _ = a.shape
    return a.reshape(b, s, n_heads, -1).transpose(0, 2, 1, 3)


def chunk_gla(q, k, v, log_g):
    bn, h, t, dk = q.shape
    dv = v.shape[-1]
    n = t // CHUNK

    def to_chunks(a):
        return jnp.moveaxis(a.reshape(bn, h, n, CHUNK, a.shape[-1]), 2, 0)

    mask = jnp.tril(jnp.ones((CHUNK, CHUNK), dtype=bool))[:, :, None]
    mask_f = mask.astype(jnp.float32)

    def step(state, inp):
        q_c, k_c, v_c, g_c = inp
        b = jnp.cumsum(g_c, axis=-2)
        o_inter = jnp.einsum('bhck,bhkv->bhcv', q_c * jnp.exp(b), state)
        diff = b[:, :, :, None, :] - b[:, :, None, :, :]
        decay = jnp.exp(jnp.where(mask, diff, 0.0)) * mask_f
        scores = jnp.einsum('bhtsk,bhsk->bhts', q_c[:, :, :, None, :] * decay, k_c)
        o = o_inter + jnp.einsum('bhts,bhsv->bhtv', scores, v_c)
        b_last = b[:, :, -1:, :]
        state = (jnp.exp(b_last[:, :, 0, :])[..., None] * state
                 + jnp.einsum('bhsk,bhsv->bhkv', k_c * jnp.exp(b_last - b), v_c))
        return state, o

    s0 = jnp.zeros((bn, h, dk, dv), jnp.float32)
    _, o = lax.scan(step, s0, (to_chunks(q), to_chunks(k), to_chunks(v), to_chunks(log_g)))
    return jnp.moveaxis(o, 0, 2).reshape(bn, h, t, dv)


def bidir_gla(q, k_f, k_b, v, g_f, g_b):
    flip = lambda a: jnp.flip(a, axis=2)
    bsz = q.shape[0]
    o = chunk_gla(jnp.concatenate([q, flip(q)], 0),
                  jnp.concatenate([k_f, flip(k_b)], 0),
                  jnp.concatenate([v, flip(v)], 0),
                  jnp.concatenate([g_f, flip(g_b)], 0))
    return o[:bsz] + flip(o[bsz:])


def gated_head_norm(o, gate, w):
    o = o * lax.rsqrt(jnp.mean(o * o, axis=-1, keepdims=True) + HEAD_EPS) * w.astype(jnp.float32)
    b, h, s, dv = o.shape
    o = o.transpose(0, 2, 1, 3).reshape(b, s, h * dv)
    return o * jax.nn.silu(gate)


def hgrn_forget(z, lb):
    f = lb + (1.0 - lb) * jax.nn.sigmoid(z)
    log_f = jnp.log(jnp.maximum(f, F_MIN))
    k = (1.0 - lb) * jax.nn.sigmoid(-z)
    return log_f, k


def swiglu(v, wg, wu, wd):
    return (jax.nn.silu(v @ wg) * (v @ wu)) @ wd


def moe_swiglu(v, w_router, wg, wu, wd):
    logits = (v @ w_router).astype(jnp.float32)
    probs = jax.nn.softmax(logits, axis=-1)
    top_w, top_i = lax.top_k(probs, TOP_K)
    top_w = top_w / jnp.sum(top_w, axis=-1, keepdims=True)
    gates = jnp.sum(jax.nn.one_hot(top_i, N_EXPERTS, dtype=jnp.float32) * top_w[..., None], axis=-2)
    y = jnp.zeros(v.shape, jnp.float32)
    for e in range(N_EXPERTS):
        y = y + gates[..., e:e + 1] * swiglu(v, wg[e], wu[e], wd[e]).astype(jnp.float32)
    return y.astype(v.dtype)


def setup_inputs(seed: int = 0) -> dict:
    key = jax.random.key(seed)
    ks = jax.random.split(key, 24)
    f32 = jnp.float32

    def nrm(k, shape, fan_in):
        return jax.random.normal(k, shape, f32) * (fan_in ** -0.5)

    def gain(k, shape):
        return 1.0 + 0.05 * jax.random.normal(k, shape, f32)

    n_dense = (DEPTH + 1) // 2
    n_moe = DEPTH // 2
    return {
        "x": jax.random.normal(ks[0], (BATCH, SEQ, D_MODEL), f32),
        "p": jax.random.normal(ks[1], (DEPTH, BATCH, SEQ, PLE_DIM), f32),
        "w_in": nrm(ks[2], (DEPTH, D_MODEL, D_IN_PROJ), D_MODEL),
        "gla_wg2": nrm(ks[3], (DEPTH, 2, GLA_RANK, GLA_QK), GLA_RANK),
        "gla_bg": 0.1 * jax.random.normal(ks[4], (DEPTH, 2, GLA_QK), f32),
        "hg_lb_logits": jax.random.normal(ks[5], (DEPTH, 2, HG_K), f32),
        "gla_onorm": gain(ks[6], (DEPTH, GLA_DV)),
        "hg_onorm": gain(ks[7], (DEPTH, HG_DV)),
        "w_out": nrm(ks[8], (DEPTH, D_MIX, D_MODEL), D_MIX),
        "norm_mix": gain(ks[9], (DEPTH, D_MODEL)),
        "norm_ffn": gain(ks[10], (DEPTH, D_MODEL)),
        "w_dense_gate": nrm(ks[11], (n_dense, D_MODEL, D_FF_DENSE), D_MODEL),
        "w_dense_up": nrm(ks[12], (n_dense, D_MODEL, D_FF_DENSE), D_MODEL),
        "w_dense_down": nrm(ks[13], (n_dense, D_FF_DENSE, D_MODEL), D_FF_DENSE),
        "w_router": nrm(ks[14], (n_moe, D_MODEL, N_EXPERTS), D_MODEL),
        "w_exp_gate": nrm(ks[15], (n_moe, N_EXPERTS, D_MODEL, D_FF_EXPERT), D_MODEL),
        "w_exp_up": nrm(ks[16], (n_moe, N_EXPERTS, D_MODEL, D_FF_EXPERT), D_MODEL),
        "w_exp_down": nrm(ks[17], (n_moe, N_EXPERTS, D_FF_EXPERT, D_MODEL), D_FF_EXPERT),
        "w_ple_proj": nrm(ks[18], (DEPTH, PLE_DIM, D_MODEL), PLE_DIM),
        "w_ple_gate": nrm(ks[19], (DEPTH, D_MODEL, D_MODEL), D_MODEL),
        "norm_ple": gain(ks[20], (DEPTH, D_MODEL)),
        "norm_final": gain(ks[21], (D_MODEL,)),
    }


def reference(x, p, w_in, gla_wg2, gla_bg, hg_lb_logits, gla_onorm, hg_onorm, w_out,
              norm_mix, norm_ffn, w_dense_gate, w_dense_up, w_dense_down, w_router,
              w_exp_gate, w_exp_up, w_exp_down, w_ple_proj, w_ple_gate, norm_ple,
              norm_final):
    f32 = jnp.float32
    offsets = np.cumsum(IN_SPLIT_SIZES)[:-1].tolist()
    lb_p = jax.nn.softmax(hg_lb_logits.astype(f32), axis=0)
    lb_all = jnp.cumsum(lb_p, axis=0) - lb_p[0:1]

    h = x
    for i in range(DEPTH):
        u = rmsnorm(h, norm_mix[i])
        proj = (u @ w_in[i]).astype(f32)
        (gq, gk, gv, gr, glr_f, glr_b,
         hq, hf_f, hf_b, hv, hr) = jnp.split(proj, offsets, axis=-1)

        wg2 = gla_wg2[i].astype(f32)
        bg = gla_bg[i].astype(f32)
        g_f = jax.nn.log_sigmoid(glr_f @ wg2[0] + bg[0]) / GLA_GATE_NORM
        g_b = jax.nn.log_sigmoid(glr_b @ wg2[1] + bg[1]) / GLA_GATE_NORM
        k_gla = to_heads(gk, GLA_HEADS)
        o_gla = bidir_gla(to_heads(gq, GLA_HEADS) * (GLA_DK ** -0.5), k_gla, k_gla,
                          to_heads(gv, GLA_HEADS),
                          to_heads(g_f, GLA_HEADS), to_heads(g_b, GLA_HEADS))
        y_gla = gated_head_norm(o_gla, gr, gla_onorm[i])

        lb = lb_all[i]
        log_f_f, k_f = hgrn_forget(hf_f, lb[0])
        log_f_b, k_b = hgrn_forget(hf_b, lb[1])
        o_hg = bidir_gla(to_heads(jax.nn.silu(hq), HG_HEADS) * (HG_DK ** -0.5),
                         to_heads(k_f, HG_HEADS), to_heads(k_b, HG_HEADS),
                         to_heads(hv, HG_HEADS),
                         to_heads(log_f_f, HG_HEADS), to_heads(log_f_b, HG_HEADS))
        y_hg = gated_head_norm(o_hg, hr, hg_onorm[i])

        mixed = jnp.concatenate([y_gla, y_hg], axis=-1).astype(h.dtype) @ w_out[i]
        h = h + mixed

        v = rmsnorm(h, norm_ffn[i])
        j = i // 2
        if i % 2 == 0:
            ffn = swiglu(v, w_dense_gate[j], w_dense_up[j], w_dense_down[j])
        else:
            ffn = moe_swiglu(v, w_router[j], w_exp_gate[j], w_exp_up[j], w_exp_down[j])
        h = h + ffn

        gate = jax.nn.sigmoid(rmsnorm(h, norm_ple[i]) @ w_ple_gate[i])
        h = h + (p[i] @ w_ple_proj[i]) * gate

    return rmsnorm(h, norm_final)
```

```cpp
#include <hip/hip_runtime.h>
#include <cstdio>
#include <cstdint>

#ifndef REP_PRO
#define REP_PRO 1
#endif
#ifndef REP_G1
#define REP_G1 1
#endif
#ifndef REP_SCAN
#define REP_SCAN 1
#endif
#ifndef REP_G5
#define REP_G5 1
#endif
#ifndef REP_G3
#define REP_G3 1
#endif
#ifndef MK_MULTI
#define MK_MULTI 0
#endif

namespace pg8 {
#define PG8_LAS __attribute__((address_space(3)))
typedef unsigned short bf16_t;
typedef short bf16x8 __attribute__((ext_vector_type(8)));
typedef float f32x4 __attribute__((ext_vector_type(4)));
typedef unsigned u32x4 __attribute__((ext_vector_type(4)));
typedef unsigned u32x2 __attribute__((ext_vector_type(2)));
constexpr int BM = 256, BK = 64, HALF = 128, HTB = HALF * BK * 2, STAGE_BYTES = 8 * HTB, NXCD = 8, WGM = 8;

__host__ __device__ __forceinline__ int lds_byte(int r, int c) { const int st = (r >> 4) * 2 + (c >> 5), rr = r & 15, cc = c & 31, ob = rr * 64 + cc * 2; return st * 1024 + (ob ^ (((ob >> 9) & 1) << 5)); }
__host__ __device__ __forceinline__ void stage_rc(int b, int& R, int& C) { const int st = b / 1024, sb = b % 1024, swz = sb ^ (((sb >> 9) & 1) << 5); R = (st >> 1) * 16 + swz / 64; C = (st & 1) * 32 + (swz % 64) / 2; }
__host__ __device__ __forceinline__ int perm32(int rho) { const int n = rho >> 4, i = rho & 15; return 8 * (i >> 2) + 4 * n + (i & 3); }

struct Unit { int pm, pn, pnl; };
struct Gemm { const bf16_t* A; const bf16_t* Bt; int K; const int* rowsrc; };

template <bool F8> struct FragT { typedef bf16x8 A[4][2]; typedef bf16x8 B[2][2]; };
typedef int v8i_t __attribute__((ext_vector_type(8)));
template <> struct FragT<true> { typedef v8i_t A[4]; typedef v8i_t B[2]; };
typedef int v4i_t __attribute__((ext_vector_type(4)));
__device__ __forceinline__ int xcd_remap(int wgid, int nwg) { const int q = nwg / NXCD, r = nwg % NXCD, xcd = wgid % NXCD, off = wgid / NXCD; return (xcd < r ? xcd * (q + 1) : r * (q + 1) + (xcd - r) * q) + off; }

struct StaticOrder {
    int nM, nN, nwg, G, c;
    __device__ void init(int M, int N, int G_, int c_) { nM = M / BM; nN = N / BM; nwg = nM * nN; G = G_; c = c_; }
    __device__ bool next(int i, Unit& u) const {
        const long L = (long)i * G + c; if (L >= nwg) return false;
        const int wgid = xcd_remap((int)L, nwg);
        const int nig = WGM * nN, gid = wgid / nig, fm = gid * WGM, gsz = (nM - fm) < WGM ? (nM - fm) : WGM;
        u.pm = fm + ((wgid % nig) % gsz); u.pn = (wgid % nig) / gsz; u.pnl = u.pn; return true;
    }
    __device__ __forceinline__ void a_ready(const Unit&) const {}
    __device__ __forceinline__ void done(const Unit&) const {}
};
struct GroupedOrder {
    unsigned cn[8]; int nN, U, G, c;
    __device__ void init(const unsigned* cnt64, int nN_, int G_, int c_) {
        int t = 0;
#pragma unroll
        for (int e = 0; e < 8; ++e) { cn[e] = (__hip_atomic_load(cnt64 + 64 * e, __ATOMIC_RELAXED, __HIP_MEMORY_SCOPE_AGENT) + 255u) >> 8; t += (int)cn[e]; }
        nN = nN_; U = t * nN; G = G_; c = c_;
    }
    __device__ bool next(int i, Unit& u) const {
        const long L = (long)i * G + c; if (L >= U) return false;
        const int w0 = xcd_remap((int)L, U);
        int base = 0, tb = 0, es = 0, bs = 0, ns = 1, ts = 0;
#pragma unroll
        for (int e = 0; e < 8; ++e) { const int n = (int)cn[e], ue = n * nN; const bool hit = (w0 >= base) && (w0 < base + ue); if (hit) { es = e; bs = base; ns = n; ts = tb; } base += ue; tb += n; }
        const int w = w0 - bs, nig = WGM * nN, gid = w / nig, fm = gid * WGM, gsz = (ns - fm) < WGM ? (ns - fm) : WGM;
        u.pm = ts + fm + ((w % nig) % gsz); u.pnl = (w % nig) / gsz; u.pn = es * nN + u.pnl; return true;
    }
    __device__ __forceinline__ void a_ready(const Unit&) const {}
    __device__ __forceinline__ void done(const Unit&) const {}
};

typedef float f32x2_t __attribute__((ext_vector_type(2)));
typedef __bf16 bf16x2_t __attribute__((ext_vector_type(2)));
__device__ __forceinline__ unsigned cvt_pk_bf16(float lo, float hi) { const f32x2_t v = {lo, hi}; const bf16x2_t b = __builtin_convertvector(v, bf16x2_t); return __builtin_bit_cast(unsigned, b); }

template <class Epi, class Sched, bool ALIGN_EPI = false, bool SP2 = false, bool GATHER = false, bool FP8 = false>
__device__ __forceinline__ void gemm_phase(PG8_LAS unsigned char* lds, const Gemm g, const Sched& S, const Epi& E, int wid_s) {
    int lane_; asm volatile("v_mbcnt_lo_u32_b32 %0, -1, 0\n\tv_mbcnt_hi_u32_b32 %0, -1, %0" : "=v"(lane_));
    const int wid = wid_s, lane = lane_, tid = wid * 64 + lane, wr = wid >> 2, wc = wid & 3, fr = lane & 15, fq = lane >> 4;
    const int K = g.K, nt = K / BK;
    unsigned voffA[2], voffB[2]; int gR[2]; unsigned gC[2];
#pragma unroll
    for (int i = 0; i < 2; ++i) { int R, C; stage_rc(tid * 16 + i * 8192, R, C); const int Rb = Epi::PERM ? ((R & ~31) + perm32(R & 31)) : R;
        voffA[i] = (unsigned)(R * K + C) * 2u; voffB[i] = (unsigned)(Rb * K + C) * 2u; gR[i] = R; gC[i] = (unsigned)C * 2u; }
    unsigned gvc[2][2], gvn[2][2];
#define PG8_GOFF(dst, un) do { if constexpr (GATHER) { _Pragma("unroll") for (int h_ = 0; h_ < 2; ++h_) _Pragma("unroll") for (int i_ = 0; i_ < 2; ++i_) \
        dst[h_][i_] = (unsigned)g.rowsrc[(un).pm * BM + h_ * HALF + gR[i_]] * (unsigned)(K * 2) + gC[i_]; } } while (0)
#define PG8_STAGE_A(bufoff, nextu, h, kbyte) do { if constexpr (GATHER) { _Pragma("unroll") for (int _i = 0; _i < 2; ++_i) \
        __builtin_amdgcn_global_load_lds((const unsigned*)((const char*)g.A + (size_t)(kbyte) + ((nextu) ? gvn[h][_i] : gvc[h][_i])), (PG8_LAS unsigned*)(lds + (bufoff) + ldsw + _i * 8192), 16, 0, 0); } \
        else { PG8_STAGE(bufoff, ((nextu) ? nA : cA) + (size_t)(h) * hstep + (size_t)(kbyte), voffA); } } while (0)
    const size_t kstep = (size_t)(BK * 2);
    const size_t hstep = (size_t)HALF * K * 2;
    const size_t tstep = 2 * hstep;
    const unsigned ldsw = (unsigned)wid * 1024u;
    const int aoff = FP8 ? lds_byte(wr * 64 + fr, fq * 16) : lds_byte(wr * 64 + fr, fq * 8), boff = FP8 ? lds_byte(wc * 32 + fr, fq * 16) : lds_byte(wc * 32 + fr, fq * 8);
#define PG8_SA(b, h) (((b) * 2 + (h)) * HTB)
#define PG8_SB(b, h) ((4 + (b) * 2 + (h)) * HTB)
#define PG8_STAGE(bufoff, gbase, voff) do { _Pragma("unroll") for (int _i = 0; _i < 2; ++_i) \
        __builtin_amdgcn_global_load_lds((const unsigned*)((const char*)(gbase) + (voff)[_i]), (PG8_LAS unsigned*)(lds + (bufoff) + ldsw + _i * 8192), 16, 0, 0); } while (0)
#define PG8_LDA(dst, b, h) do { if constexpr (FP8) { _Pragma("unroll") for (int m = 0; m < 4; ++m) { const PG8_LAS v4i_t* p_ = (const PG8_LAS v4i_t*)(lds + PG8_SA(b, h) + aoff + m * 2048); dst[m] = __builtin_shufflevector(p_[0], p_[1], 0, 1, 2, 3, 4, 5, 6, 7); } } \
        else { _Pragma("unroll") for (int m = 0; m < 4; ++m) _Pragma("unroll") for (int k = 0; k < 2; ++k) dst[m][k] = *(const PG8_LAS bf16x8*)(lds + PG8_SA(b, h) + aoff + m * 2048 + k * 1024); } } while (0)
#define PG8_LDB(dst, b, h) do { if constexpr (FP8) { _Pragma("unroll") for (int n = 0; n < 2; ++n) { const PG8_LAS v4i_t* p_ = (const PG8_LAS v4i_t*)(lds + PG8_SB(b, h) + boff + n * 2048); dst[n] = __builtin_shufflevector(p_[0], p_[1], 0, 1, 2, 3, 4, 5, 6, 7); } } \
        else { _Pragma("unroll") for (int n = 0; n < 2; ++n) _Pragma("unroll") for (int k = 0; k < 2; ++k) dst[n][k] = *(const PG8_LAS bf16x8*)(lds + PG8_SB(b, h) + boff + n * 2048 + k * 1024); } } while (0)
#define PG8_MMA(ai, bj, At, Bt) do { __builtin_amdgcn_s_setprio(1); _Pragma("unroll") for (int m = 0; m < 4; ++m) _Pragma("unroll") for (int n = 0; n < 2; ++n) { \
        if constexpr (FP8) asm volatile("v_mfma_scale_f32_16x16x128_f8f6f4 %0, %1, %2, %0, %3, %3 op_sel_hi:[0,0,0]" : "+v"(acc[ai][bj][m][n]) : "v"(Bt[n]), "v"(At[m]), "v"(one8));   \
        else { _Pragma("unroll") for (int k = 0; k < 2; ++k) acc[ai][bj][m][n] = __builtin_amdgcn_mfma_f32_16x16x32_bf16(Bt[n][k], At[m][k], acc[ai][bj][m][n], 0, 0, 0); } } __builtin_amdgcn_s_setprio(0); } while (0)
#define PG8_WAIT_V(n) asm volatile("s_waitcnt vmcnt(" #n ")" ::: "memory")
#define PG8_WAIT_L(n) asm volatile("s_waitcnt lgkmcnt(" #n ")" ::: "memory")
#define PG8_BAR __builtin_amdgcn_s_barrier()
#define PG8_SCHED __builtin_amdgcn_sched_barrier(0)
    Unit cur, nxt; int ui = 0;
    if (!S.next(0, cur)) return;
    f32x4 acc[2][2][4][2];
#pragma unroll
    for (int a = 0; a < 2; ++a)
#pragma unroll
        for (int b = 0; b < 2; ++b)
#pragma unroll
            for (int m = 0; m < 4; ++m)
#pragma unroll
                for (int n = 0; n < 2; ++n) acc[a][b][m][n] = (f32x4){0.f, 0.f, 0.f, 0.f};
    typename FragT<FP8>::A At; typename FragT<FP8>::B B0, B1; const int one8 = 0x7f7f7f7f; (void)one8;
    const char* cA = (const char*)g.A + (size_t)cur.pm * tstep; const char* cB = (const char*)g.Bt + (size_t)cur.pn * tstep;
    S.a_ready(cur);
    PG8_GOFF(gvc, cur);
    if constexpr (SP2) {
        const char* nA = cA;
        PG8_STAGE(PG8_SB(0, 0), cB, voffB); PG8_STAGE(PG8_SB(0, 1), cB + hstep, voffB); PG8_STAGE_A(PG8_SA(0, 0), false, 0, 0); PG8_STAGE_A(PG8_SA(0, 1), false, 1, 0);
        if (wr == 1) PG8_BAR;
        PG8_WAIT_V(2); PG8_BAR;
        PG8_STAGE(PG8_SB(1, 0), cB + kstep, voffB); PG8_STAGE_A(PG8_SA(1, 0), false, 0, kstep); PG8_STAGE(PG8_SB(1, 1), cB + hstep + kstep, voffB);
        PG8_WAIT_V(6); PG8_BAR;
    } else {
        PG8_STAGE(PG8_SB(0, 0), cB, voffB); PG8_STAGE(PG8_SA(0, 0), cA, voffA); PG8_STAGE(PG8_SB(0, 1), cB + hstep, voffB); PG8_STAGE(PG8_SA(0, 1), cA + hstep, voffA);
        if (wr == 1) PG8_BAR;
        PG8_WAIT_V(4); PG8_BAR;
        PG8_STAGE(PG8_SB(1, 0), cB + kstep, voffB); PG8_STAGE(PG8_SA(1, 0), cA + kstep, voffA); PG8_STAGE(PG8_SB(1, 1), cB + hstep + kstep, voffB);
        PG8_WAIT_V(6); PG8_BAR;
    }
    for (;;) {
        const bool has_next = S.next(ui + 1, nxt);
        const char* nA = has_next ? (const char*)g.A + (size_t)nxt.pm * tstep : cA; const char* nB = has_next ? (const char*)g.Bt + (size_t)nxt.pn * tstep : cB;
        if (has_next) PG8_GOFF(gvn, nxt); else { if constexpr (GATHER) { _Pragma("unroll") for (int h_ = 0; h_ < 2; ++h_) _Pragma("unroll") for (int i_ = 0; i_ < 2; ++i_) gvn[h_][i_] = gvc[h_][i_]; } }
        for (int t = 0; t < nt; t += 2) {
            const bool last = (t == nt - 2);
            const char* a1 = cA + (size_t)(t + 1) * kstep;
            const char* a2 = last ? nA : cA + (size_t)(t + 2) * kstep; const char* b2 = last ? nB : cB + (size_t)(t + 2) * kstep;
            const char* a3 = a2 + kstep; const char* b3 = b2 + kstep;
            if (last && has_next) S.a_ready(nxt);
            if constexpr (SP2) {
            const size_t k1b = (size_t)(t + 1) * kstep, k2b = last ? (size_t)0 : (size_t)(t + 2) * kstep, k3b = k2b + kstep;
            PG8_LDB(B0, 0, 0); PG8_LDB(B1, 0, 1); PG8_SCHED; PG8_LDA(At, 0, 0); PG8_STAGE_A(PG8_SA(1, 1), false, 1, k1b);
            PG8_WAIT_V(8); PG8_WAIT_L(0); PG8_BAR; PG8_MMA(0, 0, At, B0); PG8_MMA(0, 1, At, B1); PG8_BAR; PG8_SCHED;
            PG8_LDA(At, 0, 1); PG8_STAGE(PG8_SB(0, 0), b2, voffB); PG8_STAGE(PG8_SB(0, 1), b2 + hstep, voffB); PG8_STAGE_A(PG8_SA(0, 0), last, 0, k2b);
            PG8_WAIT_V(8); PG8_WAIT_L(0); PG8_BAR; PG8_MMA(1, 0, At, B0); PG8_MMA(1, 1, At, B1); PG8_BAR; PG8_SCHED;
            PG8_LDB(B0, 1, 0); PG8_LDB(B1, 1, 1); PG8_SCHED; PG8_LDA(At, 1, 0); PG8_STAGE_A(PG8_SA(0, 1), last, 1, k2b);
            PG8_WAIT_V(8); PG8_WAIT_L(0); PG8_BAR; PG8_MMA(0, 0, At, B0); PG8_MMA(0, 1, At, B1); PG8_BAR; PG8_SCHED;
            PG8_LDA(At, 1, 1); PG8_STAGE(PG8_SB(1, 0), b3, voffB); PG8_STAGE(PG8_SB(1, 1), b3 + hstep, voffB); PG8_STAGE_A(PG8_SA(1, 0), last, 0, k3b);
            PG8_WAIT_V(8); PG8_WAIT_L(0); PG8_BAR; PG8_MMA(1, 0, At, B0); PG8_MMA(1, 1, At, B1); PG8_BAR; PG8_SCHED;
            } else {
            PG8_LDB(B0, 0, 0); PG8_SCHED; PG8_LDA(At, 0, 0); PG8_STAGE(PG8_SA(1, 1), a1 + hstep, voffA);
            PG8_WAIT_L(8); PG8_BAR; PG8_WAIT_L(0); PG8_MMA(0, 0, At, B0); PG8_BAR; PG8_SCHED;
            PG8_LDB(B1, 0, 1); PG8_STAGE(PG8_SB(0, 0), b2, voffB);
            PG8_BAR; PG8_WAIT_L(0); PG8_MMA(0, 1, At, B1); PG8_BAR;
            PG8_LDA(At, 0, 1); PG8_STAGE(PG8_SA(0, 0), a2, voffA);
            PG8_BAR; PG8_WAIT_L(0); PG8_MMA(1, 0, At, B0); PG8_BAR; PG8_SCHED;
            PG8_STAGE(PG8_SB(0, 1), b2 + hstep, voffB);
            PG8_WAIT_V(6); PG8_BAR; PG8_MMA(1, 1, At, B1); PG8_BAR;
            PG8_LDB(B0, 1, 0); PG8_SCHED; PG8_LDA(At, 1, 0); PG8_STAGE(PG8_SA(0, 1), a2 + hstep, voffA);
            PG8_WAIT_L(8); PG8_BAR; PG8_WAIT_L(0); PG8_MMA(0, 0, At, B0); PG8_BAR; PG8_SCHED;
            PG8_LDB(B1, 1, 1); PG8_STAGE(PG8_SB(1, 0), b3, voffB);
            PG8_BAR; PG8_WAIT_L(0); PG8_MMA(0, 1, At, B1); PG8_BAR;
            PG8_LDA(At, 1, 1); PG8_STAGE(PG8_SA(1, 0), a3, voffA);
            PG8_BAR; PG8_WAIT_L(0); PG8_MMA(1, 0, At, B0); PG8_BAR; PG8_SCHED;
            PG8_STAGE(PG8_SB(1, 1), b3 + hstep, voffB);
            PG8_WAIT_V(6); PG8_BAR; PG8_MMA(1, 1, At, B1); PG8_BAR;
            }
        }
        if constexpr (ALIGN_EPI) { if (wr == 0) PG8_BAR; }
        E(acc, cur, wr, wc); S.done(cur);
        if (!has_next) break;
#pragma unroll
        for (int a = 0; a < 2; ++a)
#pragma unroll
            for (int b = 0; b < 2; ++b)
#pragma unroll
                for (int m = 0; m < 4; ++m)
#pragma unroll
                    for (int n = 0; n < 2; ++n) acc[a][b][m][n] = (f32x4){0.f, 0.f, 0.f, 0.f};
        cur = nxt; cA = nA; cB = nB; ++ui;
        if constexpr (GATHER) { _Pragma("unroll") for (int h_ = 0; h_ < 2; ++h_) _Pragma("unroll") for (int i_ = 0; i_ < 2; ++i_) gvc[h_][i_] = gvn[h_][i_]; }
        if constexpr (ALIGN_EPI) { if (wr == 1) PG8_BAR; }
    }
    PG8_WAIT_V(0);
    if constexpr (!ALIGN_EPI) { if (wr == 0) PG8_BAR; }
    PG8_BAR;
#undef PG8_GOFF
#undef PG8_STAGE_A
#undef PG8_SA
#undef PG8_SB
#undef PG8_STAGE
#undef PG8_LDA
#undef PG8_LDB
#undef PG8_MMA
#undef PG8_WAIT_V
#undef PG8_WAIT_L
#undef PG8_BAR
#undef PG8_SCHED
}
}

constexpr int BATCH = 2, SEQ = 8192, D = 1024, DEPTH = 4, M = BATCH * SEQ;
constexpr int DIN = 4128, NPROJ = 4608, FFD = 2816, FFE = 3584, NEXP = 8, PLE = 256;
constexpr float EPS = 1e-6f, HEAD_EPS = 1e-5f, F_MIN = 1e-6f;
#ifndef F8_DENSE
#define F8_DENSE 0
#endif
#ifndef F8_DDN
#define F8_DDN 0
#endif
#ifndef F8_EGU
#define F8_EGU 1
#endif
constexpr float F8_WMUL = 32.0f, F8_AMUL = 4.0f, F8_GMUL = 16.0f;
constexpr int PC_GQ = 0, PC_GK = 256, PC_GV = 512, PC_GR = 1024, PC_HQ = 1536, PC_HFF = 2048, PC_HFB = 2560, PC_HV = 3072, PC_HR = 3584, PC_GGF = 4096, PC_GGB = 4352;
constexpr int XG_ROWS = 34816;

constexpr size_t MiB = 1u << 20;
constexpr size_t WS_CTL = 0, CTL_ZERO_BYTES = 1 * MiB;
constexpr size_t WS_TAB = 2 * MiB;
constexpr size_t TAB_LB = 0, TAB_LTOK = 64 * 1024, TAB_LW = TAB_LTOK + 512 * 1024, TAB_RSTD = TAB_LW + 512 * 1024, TAB_RINFO = TAB_RSTD + 64 * 1024, TAB_RRSTD = TAB_RINFO + 512 * 1024, TAB_ROWTOK = TAB_RRSTD + 256 * 1024;
constexpr size_t WS_WIN = 8 * MiB;
constexpr size_t WS_WOUT = WS_WIN + 36 * MiB;
constexpr size_t WS_WGU = WS_WOUT + 8 * MiB;
constexpr size_t WS_WDN = WS_WGU + 22 * MiB;
constexpr size_t WS_WEGU = WS_WDN + 11 * MiB;
constexpr size_t WS_WEDN = WS_WEGU + 224 * MiB;
constexpr size_t WS_WPG = WS_WEDN + 112 * MiB;
constexpr size_t WS_WPP = WS_WPG + 8 * MiB;
constexpr size_t WS_HB = WS_WPP + 2 * MiB;
constexpr size_t WS_PB = WS_HB + 32 * MiB;
constexpr size_t WS_Y = WS_PB + 32 * MiB;
constexpr size_t WS_PP = WS_Y + 32 * MiB;
constexpr size_t WS_YS = WS_PP + 32 * MiB;
constexpr size_t WS_XG = WS_YS + 64 * MiB;
constexpr size_t WS_HQ = WS_XG;
constexpr size_t WS_BIG = WS_XG + 68 * MiB;
constexpr size_t WS_HBX = WS_BIG + 238 * MiB;
constexpr size_t WS_END = WS_HBX + 32 * MiB;
constexpr int CW_TMO = 0, CW_BAR = 4096, CW_CNT = 8192, CW_SS = 16384;
static_assert((CW_SS + 13 * M) * 4 <= (int)CTL_ZERO_BYTES, "ctl");

constexpr int NWAVES = 8;
constexpr int RING_OFF = 0, RING_BYTES = 131072;
constexpr int LDSCTL_OFF = RING_BYTES, MISC_OFF = LDSCTL_OFF + 320;
constexpr int LDS_BYTES = 147456;

#define GAS __attribute__((address_space(1)))
#define LAS __attribute__((address_space(3)))
typedef unsigned short bf16;
typedef unsigned v4u __attribute__((ext_vector_type(4)));
typedef unsigned v2u __attribute__((ext_vector_type(2)));
typedef float f32x4 __attribute__((ext_vector_type(4)));
typedef GAS unsigned gu32;
#define RLX_AGENT __ATOMIC_RELAXED, __HIP_MEMORY_SCOPE_AGENT
#define LDS_WAIT() asm volatile("s_waitcnt lgkmcnt(0)" ::: "memory")
#define VM_WAIT() asm volatile("s_waitcnt vmcnt(0)" ::: "memory")
__device__ __forceinline__ unsigned f2bf(float f) { unsigned u = __builtin_bit_cast(unsigned, f); return (u + 0x7fffu + ((u >> 16) & 1u)) >> 16; }
__device__ __forceinline__ unsigned pk2(float lo, float hi) { return f2bf(lo) | (f2bf(hi) << 16); }
__device__ __forceinline__ float bflo(unsigned w) { return __builtin_bit_cast(float, w << 16); }
__device__ __forceinline__ float bfhi(unsigned w) { return __builtin_bit_cast(float, w & 0xffff0000u); }
__device__ __forceinline__ float bf1(bf16 b) { return __builtin_bit_cast(float, ((unsigned)b) << 16); }
__device__ __forceinline__ float sigm(float x) { return __builtin_amdgcn_rcpf(1.0f + __expf(-x)); }
__device__ __forceinline__ float silu(float x) { return x * __builtin_amdgcn_rcpf(1.0f + __expf(-x)); }
__device__ __forceinline__ float logsig(float x) { return fminf(x, 0.f) - __logf(1.0f + __expf(-fabsf(x))); }

#define XB_TMO      128
#define XB_XCNT(j)  (256  + 64 * (j))
#define XB_XSUB(j)  (1280 + 64 * (j))
#define XB_XGEN(j)  (2304 + 64 * (j))
#define XB_TOP      3328
#define XB_TOPGEN   3392
#define XCD_BAR_WORDS 3456
#define XB_SPIN_CAP (1u << 18)
__device__ __forceinline__ unsigned xb_ld(unsigned* p)              { return __hip_atomic_load(p, __ATOMIC_RELAXED, __HIP_MEMORY_SCOPE_AGENT); }
__device__ __forceinline__ unsigned xb_add(unsigned* p, unsigned v) { return __hip_atomic_fetch_add(p, v, __ATOMIC_RELAXED, __HIP_MEMORY_SCOPE_AGENT); }
__device__ __forceinline__ unsigned xb_xcc_id() { return (unsigned)__builtin_amdgcn_s_getreg((3 << 11) | 20) & 0xFu; }
#define XB_SPIN(cond, bar) do { unsigned _sp = 0; while (cond) { __builtin_amdgcn_s_sleep(1); \
    if ((++_sp & 255u) == 0u) { if (xb_ld(&(bar)[XB_TMO])) break; if (_sp > XB_SPIN_CAP) { atomicAdd(&(bar)[XB_TMO], 1u); break; } } } } while (0)
struct XcdBarrier { unsigned* bar; unsigned x; volatile LAS unsigned* st; };
__device__ __forceinline__ XcdBarrier xcd_barrier_post(unsigned* bar, volatile LAS unsigned* st) {
    XcdBarrier b; b.bar = bar; b.x = xb_xcc_id(); b.st = st;
    if (threadIdx.x == 0) (void)xb_add(&bar[XB_XCNT(b.x)], 1u);
    return b;
}
__device__ __forceinline__ void xcd_barrier_complete(unsigned* bar, unsigned x, unsigned& nloc, unsigned& nx) {
    const unsigned G = gridDim.x * gridDim.y * gridDim.z;
    unsigned sum, cnt, mine, sp = 0u;
    for (;;) {
        sum = 0u; cnt = 0u; mine = 0u;
#pragma unroll
        for (unsigned j = 0; j < 16; ++j) { const unsigned c = xb_ld(&bar[XB_XCNT(j)]); sum += c; cnt += (c > 0u) ? 1u : 0u; mine = (j == x) ? c : mine; }
        if (sum == G) break;
        __builtin_amdgcn_s_sleep(1);
        if ((++sp & 255u) == 0u) { if (xb_ld(&bar[XB_TMO])) break; if (sp > XB_SPIN_CAP) { atomicAdd(&bar[XB_TMO], 1u); break; } }
    }
    nloc = mine > 0u ? mine : 1u; nx = cnt > 0u ? cnt : 1u;
}
__device__ __forceinline__ void xcd_barrier(const XcdBarrier& b) {
    asm volatile("s_waitcnt vmcnt(0)" ::: "memory");
    __syncthreads();
    if (threadIdx.x == 0) {
        unsigned* bar = b.bar;
        __builtin_amdgcn_s_waitcnt(0);
        unsigned nloc = b.st[0], nx = b.st[1];
        if (nloc == 0u) { xcd_barrier_complete(bar, b.x, nloc, nx); b.st[0] = nloc; b.st[1] = nx; }
        const unsigned old = xb_add(&bar[XB_XSUB(b.x)], 1u);
        const unsigned gen = old / nloc;
        if (old + 1u == (gen + 1u) * nloc) {
            __builtin_amdgcn_fence(__ATOMIC_RELEASE, "agent");
            asm volatile("s_waitcnt vmcnt(0)" ::: "memory");
            const unsigned og = xb_add(&bar[XB_TOP], 1u);
            const unsigned tg = og / nx;
            if (og + 1u == (tg + 1u) * nx) xb_add(&bar[XB_TOPGEN], 1u);
            else XB_SPIN(xb_ld(&bar[XB_TOPGEN]) == tg, bar);
            __builtin_amdgcn_fence(__ATOMIC_ACQUIRE, "agent");
            xb_add(&bar[XB_XGEN(b.x)], 1u);
            asm volatile("s_waitcnt vmcnt(0)" ::: "memory");
        } else {
            XB_SPIN(xb_ld(&bar[XB_XGEN(b.x)]) == gen, bar);
            __builtin_amdgcn_fence(__ATOMIC_ACQUIRE, "agent");
            asm volatile("s_waitcnt vmcnt(0)" ::: "memory");
        }
    }
    __syncthreads();
}

__device__ __forceinline__ int lane_id() { int l; asm volatile("v_mbcnt_lo_u32_b32 %0, -1, 0\n\tv_mbcnt_hi_u32_b32 %0, -1, %0" : "=v"(l)); return l; }
__device__ __forceinline__ int opq_s(int x) { asm volatile("" : "+s"(x)); return x; }
__device__ __forceinline__ int opq_v(int x) { asm volatile("" : "+v"(x)); return x; }
constexpr size_t WS_SSP = WS_TAB + 3 * MiB;
__device__ __forceinline__ float ss_load(const float* part, int row) {
    const f32x4* p = (const f32x4*)(part + (size_t)row * 16); const f32x4 a = p[0], b = p[1], c = p[2], d = p[3];
    return (((a[0] + a[1]) + (a[2] + a[3])) + ((b[0] + b[1]) + (b[2] + b[3]))) + (((c[0] + c[1]) + (c[2] + c[3])) + ((d[0] + d[1]) + (d[2] + d[3])));
}
using pg8::Unit; using pg8::bf16_t; using pg8::u32x4; using pg8::u32x2; using pg8::cvt_pk_bf16;
struct EpiProj {
    static constexpr bool PERM = true;
    bf16_t* P; const float* ss; const float* lb; const float* bg;
    template <int MODE> __device__ __forceinline__ void run(const f32x4 (&acc)[2][2][4][2], const Unit& u, int wr, int wc, float scale, const float* aux) const {
        const int lane_e = lane_id(), fr = lane_e & 15, fq = lane_e >> 4;
        const int pn = u.pn, row0 = u.pm * 256 + wr * 64 + fr, cw = wc * 32 + 8 * fq;
        f32x4 ax[2][2];
#pragma unroll
        for (int bj = 0; bj < 2; ++bj)
#pragma unroll
            for (int n = 0; n < 2; ++n) ax[bj][n] = (MODE >= 2) ? *(const f32x4*)(aux + bj * 128 + cw + 4 * n) : (f32x4){0.f, 0.f, 0.f, 0.f};
#pragma unroll
        for (int ai = 0; ai < 2; ++ai)
#pragma unroll
            for (int m = 0; m < 4; ++m) {
                const int row = row0 + ai * 128 + m * 16;
                const float rs = rsqrtf(ss_load(ss, row) * (1.0f / 1024.0f) + EPS);
                bf16_t* rowp = P + (size_t)row * NPROJ + pn * 256 + cw;
#pragma unroll
                for (int bj = 0; bj < 2; ++bj) {
                    float v[8];
#pragma unroll
                    for (int n = 0; n < 2; ++n)
#pragma unroll
                        for (int j = 0; j < 4; ++j) {
                            const float t = acc[ai][bj][m][n][j] * rs, a = ax[bj][n][j]; float o;
                            if (MODE == 0) o = t * scale;
                            else if (MODE == 1) o = silu(t) * scale;
                            else if (MODE == 2) { const float f = a + (1.0f - a) * sigm(t); o = __log2f(fmaxf(f, F_MIN)); }
                            else o = logsig(t + a) * (0.0625f * 1.4426950408889634f);
                            v[n * 4 + j] = o;
                        }
                    u32x4 w; w.x = cvt_pk_bf16(v[0], v[1]); w.y = cvt_pk_bf16(v[2], v[3]); w.z = cvt_pk_bf16(v[4], v[5]); w.w = cvt_pk_bf16(v[6], v[7]);
                    *(u32x4*)(rowp + bj * 128) = w;
                }
            }
    }
    __device__ __forceinline__ void operator()(const f32x4 (&acc)[2][2][4][2], const Unit& u, int wr, int wc) const {
        const int pn = u.pn;
        if (pn == 0) run<0>(acc, u, wr, wc, 0.125f, nullptr);
        else if (pn == 4 || pn == 5 || pn == 14 || pn == 15) run<1>(acc, u, wr, wc, 1.f, nullptr);
        else if (pn == 6 || pn == 7) run<1>(acc, u, wr, wc, 0.08838834764831845f, nullptr);
        else if (pn >= 8 && pn <= 11) run<2>(acc, u, wr, wc, 1.f, lb + ((pn - 8) >> 1) * 512 + ((pn - 8) & 1) * 256);
        else if (pn >= 16) run<3>(acc, u, wr, wc, 1.f, bg + (pn - 16) * 256);
        else run<0>(acc, u, wr, wc, 1.f, nullptr);
    }
};
template <int KIND> struct EpiRes {
    static constexpr bool PERM = false;
    const bf16_t* hin; bf16_t* hout; float* ss_out; const float* ss_in; const bf16_t* pp; unsigned char* hq; float ascale;
    __device__ __forceinline__ void operator()(const f32x4 (&acc)[2][2][4][2], const Unit& u, int wr, int wc) const {
        const int lane_e = lane_id(), fr = lane_e & 15, fq = lane_e >> 4;
        const int row0 = u.pm * 256 + wr * 64 + fr, col0 = u.pn * 256 + wc * 32 + 4 * fq;
#pragma unroll
        for (int ai = 0; ai < 2; ++ai)
#pragma unroll
            for (int m = 0; m < 4; ++m) {
                const int row = row0 + ai * 128 + m * 16; float rs = 0.f, sq = 0.f;
                if (KIND == 1) rs = rsqrtf(ss_load(ss_in, row) * (1.0f / 1024.0f) + EPS);
#pragma unroll
                for (int bj = 0; bj < 2; ++bj)
#pragma unroll
                    for (int n = 0; n < 2; ++n) {
                        const size_t off = (size_t)row * D + col0 + bj * 128 + n * 16;
                        const u32x2 hw = *(const u32x2*)(hin + off); const f32x4 a = acc[ai][bj][m][n];
                        f32x4 hv = (f32x4){bflo(hw.x), bfhi(hw.x), bflo(hw.y), bfhi(hw.y)};
                        if (KIND == 1) { const u32x2 pw = *(const u32x2*)(pp + off);
                            hv[0] += bflo(pw.x) * sigm(a[0] * rs); hv[1] += bfhi(pw.x) * sigm(a[1] * rs); hv[2] += bflo(pw.y) * sigm(a[2] * rs); hv[3] += bfhi(pw.y) * sigm(a[3] * rs);
                        } else hv += a * ascale;
                        u32x2 w; w.x = cvt_pk_bf16(hv[0], hv[1]); w.y = cvt_pk_bf16(hv[2], hv[3]); *(u32x2*)(hout + off) = w;
                        if (KIND == 0 && hq) { int q8 = 0; q8 = __builtin_amdgcn_cvt_pk_fp8_f32(hv[0], hv[1], q8, false); q8 = __builtin_amdgcn_cvt_pk_fp8_f32(hv[2], hv[3], q8, true); *(int*)(hq + off) = q8; }
                        const float r0 = bflo(w.x), r1 = bfhi(w.x), r2 = bflo(w.y), r3 = bfhi(w.y);
                        sq += (r0 * r0 + r1 * r1) + (r2 * r2 + r3 * r3);
                    }
                sq += __shfl_xor(sq, 16); sq += __shfl_xor(sq, 32);
                if (fq == 0) ss_out[(size_t)row * 16 + u.pn * 4 + wc] = sq;
                asm volatile("" ::: "memory");
            }
    }
};
template <bool F8OUT> struct EpiSwiGLU {
    static constexpr bool PERM = true;
    bf16_t* O; int ldo; const float* ss; const float* rdir; float ascale;
    __device__ __forceinline__ void operator()(const f32x4 (&acc)[2][2][4][2], const Unit& u, int wr, int wc) const {
        const int lane_e = lane_id(), fr = lane_e & 15, fq = lane_e >> 4;
        const int row0 = u.pm * 256 + wr * 64 + fr, oc = u.pnl * 128 + wc * 32 + 8 * fq;
#pragma unroll
        for (int ai = 0; ai < 2; ++ai)
#pragma unroll
            for (int m = 0; m < 4; ++m) {
                const int row = row0 + ai * 128 + m * 16;
                const float rs = (rdir ? rdir[row] : rsqrtf(ss_load(ss, row) * (1.0f / 1024.0f) + EPS)) * ascale;
                float v[8];
#pragma unroll
                for (int n = 0; n < 2; ++n)
#pragma unroll
                    for (int j = 0; j < 4; ++j) v[n * 4 + j] = silu(acc[ai][0][m][n][j] * rs) * (acc[ai][1][m][n][j] * rs);
                if (F8OUT) { int w0 = 0, w1 = 0;
                    w0 = __builtin_amdgcn_cvt_pk_fp8_f32(v[0] * F8_AMUL, v[1] * F8_AMUL, w0, false); w0 = __builtin_amdgcn_cvt_pk_fp8_f32(v[2] * F8_AMUL, v[3] * F8_AMUL, w0, true);
                    w1 = __builtin_amdgcn_cvt_pk_fp8_f32(v[4] * F8_AMUL, v[5] * F8_AMUL, w1, false); w1 = __builtin_amdgcn_cvt_pk_fp8_f32(v[6] * F8_AMUL, v[7] * F8_AMUL, w1, true);
                    *(u32x2*)((unsigned char*)O + (size_t)row * ldo + oc) = (u32x2){(unsigned)w0, (unsigned)w1}; }
                else { u32x4 w; w.x = cvt_pk_bf16(v[0], v[1]); w.y = cvt_pk_bf16(v[2], v[3]); w.z = cvt_pk_bf16(v[4], v[5]); w.w = cvt_pk_bf16(v[6], v[7]);
                    *(u32x4*)(O + (size_t)row * ldo + oc) = w; }
            }
    }
};
struct EpiScatter {
    static constexpr bool PERM = true;
    bf16_t* YS; const int2* rinfo;
    __device__ __forceinline__ void operator()(const f32x4 (&acc)[2][2][4][2], const Unit& u, int wr, int wc) const {
        const int lane_e = lane_id(), fr = lane_e & 15, fq = lane_e >> 4;
        const int row0 = u.pm * 256 + wr * 64 + fr, oc = u.pnl * 256 + wc * 32 + 8 * fq;
#pragma unroll
        for (int ai = 0; ai < 2; ++ai)
#pragma unroll
            for (int m = 0; m < 4; ++m) {
                const int2 ri = rinfo[row0 + ai * 128 + m * 16];
                if (ri.x >= 0) {
                    const int tok = ri.x & 0xffff, rank = (ri.x >> 16) & 1; const float wgt = __int_as_float(ri.y) * (1.0f / (F8_WMUL * F8_AMUL));
                    bf16_t* rowp = YS + ((size_t)rank * M + tok) * D + oc;
#pragma unroll
                    for (int bj = 0; bj < 2; ++bj) { const f32x4 a0 = acc[ai][bj][m][0] * wgt, a1 = acc[ai][bj][m][1] * wgt;
                        u32x4 w; w.x = cvt_pk_bf16(a0[0], a0[1]); w.y = cvt_pk_bf16(a0[2], a0[3]); w.z = cvt_pk_bf16(a1[0], a1[1]); w.w = cvt_pk_bf16(a1[2], a1[3]);
                        *(u32x4*)(rowp + bj * 128) = w; }
                }
            }
    }
};
struct EpiBf16Plain {
    static constexpr bool PERM = false;
    bf16_t* O;
    __device__ __forceinline__ void operator()(const f32x4 (&acc)[2][2][4][2], const Unit& u, int wr, int wc) const {
        const int lane_e = lane_id(), fr = lane_e & 15, fq = lane_e >> 4;
        const int row0 = u.pm * 256 + wr * 64 + fr, col0 = u.pn * 256 + wc * 32 + 4 * fq;
#pragma unroll
        for (int ai = 0; ai < 2; ++ai)
#pragma unroll
            for (int m = 0; m < 4; ++m)
#pragma unroll
                for (int bj = 0; bj < 2; ++bj)
#pragma unroll
                    for (int n = 0; n < 2; ++n) { const f32x4 a = acc[ai][bj][m][n]; u32x2 w; w.x = cvt_pk_bf16(a[0], a[1]); w.y = cvt_pk_bf16(a[2], a[3]);
                        *(u32x2*)(O + (size_t)(row0 + ai * 128 + m * 16) * D + col0 + bj * 128 + n * 16) = w; }
    }
};

struct Args { const float* in[22]; float* out; unsigned char* ws; int ph_lo, ph_hi; };
enum { I_X = 0, I_P, I_WIN, I_WG2, I_BG, I_LBL, I_GON, I_HON, I_WOUT, I_NMIX, I_NFFN, I_WDG, I_WDU, I_WDD, I_WR, I_WEG, I_WEU, I_WED, I_WPP, I_WPG, I_NPLE, I_NFIN };

__device__ __forceinline__ float wave_sum(float v) {
#pragma unroll
    for (int o = 1; o < 64; o <<= 1) v += __shfl_xor(v, o);
    return v;
}

__device__ __forceinline__ void tr_writeout(bf16* WT, int K, int drow, int k0, LAS float* scr, int lane) {
    LDS_WAIT(); asm volatile("" ::: "memory");
    const int c = lane & 7;
#pragma unroll
    for (int j = 0; j < 4; ++j) { const int n = (lane >> 3) + 8 * j; const LAS float* s = scr + (8 * c) * 33 + n;
        v4u o; o.x = pk2(s[0 * 33], s[1 * 33]); o.y = pk2(s[2 * 33], s[3 * 33]); o.z = pk2(s[4 * 33], s[5 * 33]); o.w = pk2(s[6 * 33], s[7 * 33]);
        *(GAS v4u*)(WT + (size_t)(drow + n) * K + k0 + 8 * c) = o; }
    LDS_WAIT(); asm volatile("" ::: "memory");
}
__device__ __forceinline__ void tr_item(const float* W, int ldn, int K, int scol, bf16* WT, int drow, int k0, const float* scale, LAS float* scr, int lane) {
#pragma unroll 8
    for (int i = 0; i < 32; ++i) { const int kk = 2 * i + (lane >> 5); float v = W[(size_t)(k0 + kk) * ldn + scol + (lane & 31)]; if (scale) v *= scale[k0 + kk]; scr[kk * 33 + (lane & 31)] = v; }
    tr_writeout(WT, K, drow, k0, scr, lane);
}

struct Desc { const float* W; int ldn, K, ncols, scol0; bf16* WT; int drow0, ilv; const float* scale; float f8mul; };
constexpr int ND = 74;
typedef const __attribute__((address_space(4))) Args* KArgs;
__device__ __forceinline__ KArgs kargs() { KArgs p = (KArgs)__builtin_amdgcn_kernarg_segment_ptr(); asm volatile("" : "+s"(p)); return p; }
__device__ __forceinline__ Desc get_desc(KArgs ap, int d) {
    Desc r; unsigned char* ws = ap->ws; const float* const* in_ = nullptr; (void)in_;
    if (d < 20) { const int i = d / 5, q = d % 5;
        if (q == 0) r = Desc{ap->in[I_WIN] + (size_t)i * D * DIN, DIN, D, 1536, 0, (bf16*)(ws + WS_WIN) + (size_t)i * NPROJ * D, 0, 0, ap->in[I_NMIX] + i * D};
        else if (q == 1) r = Desc{ap->in[I_WIN] + (size_t)i * D * DIN, DIN, D, 2560, 1568, (bf16*)(ws + WS_WIN) + (size_t)i * NPROJ * D, 1536, 0, ap->in[I_NMIX] + i * D};
        else if (q == 2) r = Desc{ap->in[I_WOUT] + (size_t)i * D * D, D, D, D, 0, (bf16*)(ws + WS_WOUT) + (size_t)i * D * D, 0, 0, nullptr};
        else if (q == 3) r = Desc{ap->in[I_WPG] + (size_t)i * D * D, D, D, D, 0, (bf16*)(ws + WS_WPG) + (size_t)i * D * D, 0, 0, ap->in[I_NPLE] + i * D};
        else r = Desc{ap->in[I_WPP] + (size_t)i * PLE * D, D, PLE, D, 0, (bf16*)(ws + WS_WPP) + (size_t)i * D * PLE, 0, 0, nullptr};
    } else if (d < 26) { const int j = (d - 20) / 3, q = (d - 20) % 3;
#if F8_DENSE
        if (q == 0) r = Desc{ap->in[I_WDG] + (size_t)j * D * FFD, FFD, D, FFD, 0, (bf16*)((unsigned char*)(ws + WS_WGU) + (size_t)j * 2 * FFD * D), 0, 1, ap->in[I_NFFN] + (2 * j) * D, F8_GMUL};
        else if (q == 1) r = Desc{ap->in[I_WDU] + (size_t)j * D * FFD, FFD, D, FFD, 0, (bf16*)((unsigned char*)(ws + WS_WGU) + (size_t)j * 2 * FFD * D), 0, 2, ap->in[I_NFFN] + (2 * j) * D, F8_GMUL};
        else r = Desc{ap->in[I_WDD] + (size_t)j * FFD * D, D, FFD, D, 0, (bf16*)((unsigned char*)(ws + WS_WDN) + (size_t)j * D * FFD), 0, 0, nullptr, F8_WMUL};
#else
        if (q == 0) r = Desc{ap->in[I_WDG] + (size_t)j * D * FFD, FFD, D, FFD, 0, (bf16*)(ws + WS_WGU) + (size_t)j * 2 * FFD * D, 0, 1, ap->in[I_NFFN] + (2 * j) * D};
        else if (q == 1) r = Desc{ap->in[I_WDU] + (size_t)j * D * FFD, FFD, D, FFD, 0, (bf16*)(ws + WS_WGU) + (size_t)j * 2 * FFD * D, 0, 2, ap->in[I_NFFN] + (2 * j) * D};
#if F8_DDN
        else r = Desc{ap->in[I_WDD] + (size_t)j * FFD * D, D, FFD, D, 0, (bf16*)((unsigned char*)(ws + WS_WDN) + (size_t)j * D * FFD), 0, 0, nullptr, F8_WMUL};
#else
        else r = Desc{ap->in[I_WDD] + (size_t)j * FFD * D, D, FFD, D, 0, (bf16*)(ws + WS_WDN) + (size_t)j * D * FFD, 0, 0, nullptr};
#endif
#endif
    } else { const int je = (d - 26) / 3, q = (d - 26) % 3, j = je / 8;
#if F8_EGU
        if (q == 0) r = Desc{ap->in[I_WEG] + (size_t)je * D * FFE, FFE, D, FFE, 0, (bf16*)((unsigned char*)(ws + WS_WEGU) + (size_t)je * 2 * FFE * D), 0, 1, ap->in[I_NFFN] + (2 * j + 1) * D, F8_GMUL};
        else if (q == 1) r = Desc{ap->in[I_WEU] + (size_t)je * D * FFE, FFE, D, FFE, 0, (bf16*)((unsigned char*)(ws + WS_WEGU) + (size_t)je * 2 * FFE * D), 0, 2, ap->in[I_NFFN] + (2 * j + 1) * D, F8_GMUL};
#else
        if (q == 0) r = Desc{ap->in[I_WEG] + (size_t)je * D * FFE, FFE, D, FFE, 0, (bf16*)(ws + WS_WEGU) + (size_t)je * 2 * FFE * D, 0, 1, ap->in[I_NFFN] + (2 * j + 1) * D};
        else if (q == 1) r = Desc{ap->in[I_WEU] + (size_t)je * D * FFE, FFE, D, FFE, 0, (bf16*)(ws + WS_WEGU) + (size_t)je * 2 * FFE * D, 0, 2, ap->in[I_NFFN] + (2 * j + 1) * D};
#endif
        else r = Desc{ap->in[I_WED] + (size_t)je * FFE * D, D, FFE, D, 0, (bf16*)((unsigned char*)(ws + WS_WEDN) + (size_t)je * D * FFE), 0, 0, nullptr, F8_WMUL};
    }
    return r;
}


constexpr int ND_PRO = 50;
__device__ __forceinline__ void convert_descs(KArgs A, int d_lo, int d_hi, int gwv, int ngw, LAS float* scr, int lane) {
    struct ItemRef { const float* src; const float* sc; bf16* dst; int ldn, K; float f8; };
    int d_ = d_lo, it_ = -1, base_ = 0;
#define PRO_NEXT(ok_, ref_) do { ok_ = false; while (d_ < d_hi) { const Desc ds = get_desc(A, d_); const int nnb = ds.ncols / 32, ni = (ds.K / 64) * nnb; \
        if (it_ < 0) { int f_ = (gwv - base_) % ngw; if (f_ < 0) f_ += ngw; it_ = f_; } \
        if (it_ < ni) { const int kb = it_ / nnb, nb = it_ % nnb, c = 32 * nb; const int drow = ds.ilv ? (ds.drow0 + 256 * (c / 128) + 128 * (ds.ilv - 1) + (c % 128)) : (ds.drow0 + c); \
            ref_.src = ds.W + (size_t)(64 * kb) * ds.ldn + ds.scol0 + c; ref_.sc = ds.scale ? ds.scale + 64 * kb : nullptr; ref_.f8 = ds.f8mul; ref_.dst = ds.f8mul != 0.f ? (bf16*)((unsigned char*)ds.WT + (size_t)drow * ds.K + 64 * kb) : ds.WT + (size_t)drow * ds.K + 64 * kb; ref_.ldn = ds.ldn; ref_.K = ds.K; it_ += ngw; ok_ = true; break; } \
        base_ = (base_ + ni) % ngw; ++d_; it_ = -1; } } while (0)
#define PRO_LOAD(v_, ref_) do { const float* p_ = ref_.src + (size_t)(lane >> 5) * ref_.ldn + (lane & 31); const size_t st_ = (size_t)2 * ref_.ldn; \
        _Pragma("unroll") for (int i = 0; i < 32; ++i) v_[i] = p_[i * st_]; } while (0)
#define PRO_PROC(v_, ref_) do { \
        _Pragma("unroll") for (int i = 0; i < 32; ++i) scr[(2 * i + (lane >> 5)) * 33 + (lane & 31)] = v_[i]; \
        LDS_WAIT(); asm volatile("" ::: "memory"); \
        const int c_ = lane & 7; f32x4 s0_ = (f32x4){1.f, 1.f, 1.f, 1.f}, s1_ = s0_; if (ref_.sc) { s0_ = *(const f32x4*)(ref_.sc + 8 * c_); s1_ = *(const f32x4*)(ref_.sc + 8 * c_ + 4); } \
        _Pragma("unroll") for (int j = 0; j < 4; ++j) { const int n_ = (lane >> 3) + 8 * j; const LAS float* s_ = scr + (8 * c_) * 33 + n_; \
            if (ref_.f8 != 0.f) { const float m_ = ref_.f8; int w0_ = 0, w1_ = 0; \
                w0_ = __builtin_amdgcn_cvt_pk_fp8_f32(s_[0 * 33] * s0_[0] * m_, s_[1 * 33] * s0_[1] * m_, w0_, false); w0_ = __builtin_amdgcn_cvt_pk_fp8_f32(s_[2 * 33] * s0_[2] * m_, s_[3 * 33] * s0_[3] * m_, w0_, true); \
                w1_ = __builtin_amdgcn_cvt_pk_fp8_f32(s_[4 * 33] * s1_[0] * m_, s_[5 * 33] * s1_[1] * m_, w1_, false); w1_ = __builtin_amdgcn_cvt_pk_fp8_f32(s_[6 * 33] * s1_[2] * m_, s_[7 * 33] * s1_[3] * m_, w1_, true); \
                *(GAS v2u*)((unsigned char*)ref_.dst + (size_t)n_ * ref_.K + 8 * c_) = (v2u){(unsigned)w0_, (unsigned)w1_}; } \
            else { v4u o_; o_.x = pk2(s_[0 * 33] * s0_[0], s_[1 * 33] * s0_[1]); o_.y = pk2(s_[2 * 33] * s0_[2], s_[3 * 33] * s0_[3]); o_.z = pk2(s_[4 * 33] * s1_[0], s_[5 * 33] * s1_[1]); o_.w = pk2(s_[6 * 33] * s1_[2], s_[7 * 33] * s1_[3]); \
            *(GAS v4u*)(ref_.dst + (size_t)n_ * ref_.K + 8 * c_) = o_; } } \
        LDS_WAIT(); asm volatile("" ::: "memory"); } while (0)
    ItemRef ra, rb; bool oka, okb; float va[32], vb[32];
    PRO_NEXT(oka, ra); if (oka) PRO_LOAD(va, ra);
    while (oka) {
        PRO_NEXT(okb, rb); if (okb) PRO_LOAD(vb, rb);
        PRO_PROC(va, ra);
        if (!okb) break;
        PRO_NEXT(oka, ra); if (oka) PRO_LOAD(va, ra);
        PRO_PROC(vb, rb);
    }
#undef PRO_NEXT
#undef PRO_LOAD
#undef PRO_PROC
}

namespace scan {
typedef short s16x8 __attribute__((ext_vector_type(8)));
typedef short s16x4 __attribute__((ext_vector_type(4)));
typedef short v4i16_t __attribute__((ext_vector_type(4)));
__device__ __forceinline__ s16x4 vtr(const LAS unsigned char* p) { return __builtin_bit_cast(s16x4, __builtin_amdgcn_ds_read_tr16_b64_v4i16((LAS v4i16_t*)p)); }
__device__ __forceinline__ s16x8 cat(s16x4 a, s16x4 b) { return __builtin_shufflevector(a, b, 0, 1, 2, 3, 4, 5, 6, 7); }
__device__ __forceinline__ f32x4 mma(s16x8 a, s16x8 b, f32x4 c) { return __builtin_amdgcn_mfma_f32_16x16x32_bf16(a, b, c, 0, 0, 0); }
__device__ __forceinline__ s16x8 tri_pat(int g, int c16, int pi) { s16x8 r;
#pragma unroll
    for (int j = 0; j < 8; ++j) r[j] = (8 * g + j <= c16 + 16 * pi) ? (short)0x3F80 : (short)0;
    return r; }
__device__ __forceinline__ v2u pack4(float a, float b, float c, float d) { v2u r; r.x = pg8::cvt_pk_bf16(a, b); r.y = pg8::cvt_pk_bf16(c, d); return r; }

constexpr size_t E_G_OFF = 0, E_H_OFF = 16 * MiB, D_OFF = 48 * MiB;
__device__ __forceinline__ size_t e_index(int unit, int dir, int w, int ndt, int dt, int lane) { return ((((size_t)unit * 2 + dir) * 8 + w) * ndt + dt) * 64 + lane; }
__device__ __forceinline__ size_t d_index(int grp, int seq, int dir, int seg, int dim) { return ((((size_t)grp * 8 + seq) * 2 + dir) * 32 + seg) * 128 + dim; }

#define EX2(x) __builtin_amdgcn_exp2f(x)
__device__ __forceinline__ float dppf(float x, int ctrl_sel) {
    const int xi = __builtin_bit_cast(int, x); int r;
    if (ctrl_sel == 0) r = __builtin_amdgcn_update_dpp(0, xi, 0xB1, 0xF, 0xF, true);
    else if (ctrl_sel == 1) r = __builtin_amdgcn_update_dpp(0, xi, 0x4E, 0xF, 0xF, true);
    else if (ctrl_sel == 2) r = __builtin_amdgcn_update_dpp(0, xi, 0x141, 0xF, 0xF, true);
    else r = __builtin_amdgcn_update_dpp(0, xi, 0x140, 0xF, 0xF, true);
    return __builtin_bit_cast(float, r); }
__device__ __forceinline__ float row16_sum(float x) { x += dppf(x, 0); x += dppf(x, 1); x += dppf(x, 2); x += dppf(x, 3); return x; }
template <int DK, bool HG, bool PB>
__device__ __forceinline__ void scan_unit(const bf16* P, float* OFf, f32x4* Ebuf, float* Dbuf, bf16* Y, const float* onw, int unit, LAS unsigned char* lds, int w, int lane) {
    constexpr int RS = DK * 2 + 16, NDT = DK / 16, NKS = DK / 32, PPR = DK / 8;
    constexpr int QT = 0, GT = 64 * RS, KT = 2 * 64 * RS, VT = 3 * 64 * RS, AT = VT + 64 * 272, VEC = AT + 64 * 144, HN = 98304;
    static_assert(VEC + 2 * 3 * 128 * 4 <= HN, "scan LDS map");
    const int lane0 = lane;
#define SCAN_LANE() const int ln_ = opq_v(lane0), g = ln_ >> 4, c16 = ln_ & 15, q4 = c16 >> 2, p4 = c16 & 3, tid = w * 64 + ln_; (void)g; (void)c16; (void)q4; (void)p4; (void)tid;

    const int seq = unit >> 5, seg = unit & 31, b = seq >> 2, hh = seq & 3;
    const int qc = HG ? PC_HQ + hh * 128 : PC_GQ + hh * 64, kc = PC_GK + hh * 64, vc = (HG ? PC_HV : PC_GV) + hh * 128;
#define SCAN_GATEC ((HG ? PC_HR : PC_GR) + hh * 128 + 16 * w + c16)
#define SCAN_YCOL ((HG ? 512 : 0) + hh * 128 + 16 * w + c16)
    const int tok0 = b * SEQ + seg * 256;
    const int cdt = HG ? w : (w >> 1), ctt0 = HG ? 0 : 2 * (w & 1), cntt = HG ? 4 : 2;
    f32x4 S[NDT]; f32x4 dlog = (f32x4){0.f, 0.f, 0.f, 0.f};
    v4u stq[2], stg[2], stk, stv[2];
#define SCAN_TOK(stp_, tau_) (tok0 + 64 * (((stp_) >> 2) ? 3 - ((stp_) & 3) : ((stp_) & 3)) + (((stp_) >> 2) ? 63 - (tau_) : (tau_)))
#define SCAN_ISSUE(stp_) do { const int dir_ = (stp_) >> 2; const int gcol_ = HG ? ((dir_ ? PC_HFB : PC_HFF) + hh * 128) : ((dir_ ? PC_GGB : PC_GGF) + hh * 64); \
        _Pragma("unroll") for (int i_ = 0; i_ < PPR / 8; ++i_) { const int p_ = tid + 512 * i_, row_ = p_ / PPR, ch_ = p_ % PPR; const bf16* rp_ = P + (size_t)SCAN_TOK(stp_, row_) * NPROJ + 8 * ch_; \
            if (PB) stq[i_] = *(const v4u*)(rp_ + qc); stg[i_] = *(const v4u*)(rp_ + gcol_); if (!HG) stk = *(const v4u*)(rp_ + kc); } \
        _Pragma("unroll") for (int i_ = 0; i_ < 2; ++i_) { const int p_ = tid + 512 * i_, row_ = p_ >> 4, ch_ = p_ & 15; stv[i_] = *(const v4u*)(P + (size_t)SCAN_TOK(stp_, row_) * NPROJ + vc + 8 * ch_); } } while (0)
#define SCAN_WRITE() do { \
        _Pragma("unroll") for (int i_ = 0; i_ < PPR / 8; ++i_) { const int p_ = tid + 512 * i_, row_ = p_ / PPR, ch_ = p_ % PPR; \
            if (PB) *(LAS v4u*)(lds + QT + row_ * RS + ch_ * 16) = stq[i_]; *(LAS v4u*)(lds + GT + row_ * RS + ch_ * 16) = stg[i_]; if (!HG) *(LAS v4u*)(lds + KT + row_ * RS + ch_ * 16) = stk; } \
        _Pragma("unroll") for (int i_ = 0; i_ < 2; ++i_) { const int p_ = tid + 512 * i_, row_ = p_ >> 4, ch_ = p_ & 15; *(LAS v4u*)(lds + VT + row_ * 272 + ch_ * 16) = stv[i_]; } } while (0)
    { SCAN_LANE() SCAN_ISSUE(0); }
    for (int stp = 0; stp < 8; ++stp) {
        const int dir = stp >> 2, ci = stp & 3;
        if (ci == 0) {
#pragma unroll
            for (int dt = 0; dt < NDT; ++dt) S[dt] = PB ? Ebuf[e_index(unit, dir, w, NDT, dt, lane0)] : (f32x4){0.f, 0.f, 0.f, 0.f};
            dlog = (f32x4){0.f, 0.f, 0.f, 0.f};
        }
        { SCAN_LANE() SCAN_WRITE(); }
        asm volatile("" ::: "memory");
        if (stp < 7) { SCAN_LANE() SCAN_ISSUE(stp + 1); }
        asm volatile("" ::: "memory");
        f32x4 o[4]; bf16 gate[16];
        if (PB) {
            SCAN_LANE()
#pragma unroll
            for (int tm = 0; tm < 4; ++tm) { o[tm] = (f32x4){0.f, 0.f, 0.f, 0.f};
                if (dir) {
#pragma unroll
                    for (int e = 0; e < 4; ++e) o[tm][e] = OFf[(unsigned)(SCAN_TOK(stp, 4 * g) * D + SCAN_YCOL - (16 * tm + e) * D)]; } }
            if (dir) {
#pragma unroll
                for (int tm = 0; tm < 4; ++tm)
#pragma unroll
                    for (int e = 0; e < 4; ++e) gate[tm * 4 + e] = P[(unsigned)(SCAN_TOK(stp, 4 * g) * NPROJ + SCAN_GATEC - (16 * tm + e) * NPROJ)];
            }
        }
        __syncthreads();
        LAS unsigned char* vecb = lds + VEC + (stp & 1) * 1536;
        {
            SCAN_LANE()
            const s16x8 pat0 = tri_pat(g, c16, 0), pat1 = tri_pat(g, c16, 1);
            s16x8 ones;
#pragma unroll
            for (int j = 0; j < 8; ++j) ones[j] = (short)0x3F80;
            s16x8 ga[2];
#pragma unroll
            for (int ks = 0; ks < 2; ++ks) ga[ks] = cat(vtr(lds + GT + (32 * ks + 8 * g + q4) * RS + (16 * cdt + 4 * p4) * 2), vtr(lds + GT + (32 * ks + 8 * g + 4 + q4) * RS + (16 * cdt + 4 * p4) * 2));
            const f32x4 z4 = (f32x4){0.f, 0.f, 0.f, 0.f};
            const f32x4 r = mma(ga[0], ones, z4), bl = mma(ga[1], ones, r);
#pragma unroll
            for (int ti = 0; ti < cntt; ++ti) { const int tt = ctt0 + ti;
                f32x4 bb;
                if (tt < 2) bb = mma(ga[0], (tt & 1) ? pat1 : pat0, z4); else bb = mma(ga[1], (tt & 1) ? pat1 : pat0, r);
                const int off = (16 * tt + c16) * RS + (16 * cdt + 4 * g) * 2;
                if (PB) {
                    const v2u qw = *(const LAS v2u*)(lds + QT + off);
                    const float e0 = EX2(bb[0] - r[0]), e1 = EX2(bb[1] - r[1]), e2 = EX2(bb[2] - r[2]), e3 = EX2(bb[3] - r[3]);
                    *(LAS v2u*)(lds + QT + off) = pack4(bflo(qw.x) * e0, bfhi(qw.x) * e1, bflo(qw.y) * e2, bfhi(qw.y) * e3);
                }
                float k0, k1, k2, k3;
                if (HG) { const v2u gw = *(const LAS v2u*)(lds + GT + off); k0 = 1.0f - EX2(bflo(gw.x)); k1 = 1.0f - EX2(bfhi(gw.x)); k2 = 1.0f - EX2(bflo(gw.y)); k3 = 1.0f - EX2(bfhi(gw.y)); }
                else { const v2u kw = *(const LAS v2u*)(lds + KT + off); k0 = bflo(kw.x); k1 = bfhi(kw.x); k2 = bflo(kw.y); k3 = bfhi(kw.y); }
                const f32x4 ref = PB ? r : bl;
                *(LAS v2u*)(lds + KT + off) = pack4(k0 * EX2(ref[0] - bb[0]), k1 * EX2(ref[1] - bb[1]), k2 * EX2(ref[2] - bb[2]), k3 * EX2(ref[3] - bb[3]));
            }
            if (c16 == 0 && (HG || (w & 1) == 0)) {
                LAS f32x4* vp = (LAS f32x4*)(vecb + (16 * cdt + 4 * g) * 4);
                vp[0] = (f32x4){EX2(r[0]), EX2(r[1]), EX2(r[2]), EX2(r[3])};
                vp[32] = (f32x4){EX2(bl[0]), EX2(bl[1]), EX2(bl[2]), EX2(bl[3])};
                vp[64] = (f32x4){EX2(bl[0] - r[0]), EX2(bl[1] - r[1]), EX2(bl[2] - r[2]), EX2(bl[3] - r[3])};
            }
            dlog += bl;
        }
        __syncthreads();
        if (PB) {
            { SCAN_LANE()
#pragma unroll
            for (int ii = 0; ii < 2; ++ii) { const int idx = 2 * w + ii, sn = idx >> 2, tm = idx & 3;
                v2u wv = (v2u){0u, 0u};
                if (sn <= tm) {
                    f32x4 a = (f32x4){0.f, 0.f, 0.f, 0.f};
#pragma unroll
                    for (int ks = 0; ks < NKS; ++ks) a = mma(*(const LAS s16x8*)(lds + KT + (16 * sn + c16) * RS + (32 * ks + 8 * g) * 2), *(const LAS s16x8*)(lds + QT + (16 * tm + c16) * RS + (32 * ks + 8 * g) * 2), a);
                    if (sn == tm) {
#pragma unroll
                        for (int e = 0; e < 4; ++e) a[e] = (4 * g + e <= c16) ? a[e] : 0.f;
                    }
                    wv = pack4(a[0], a[1], a[2], a[3]);
                }
                *(LAS v2u*)(lds + AT + (16 * tm + c16) * 144 + (16 * sn + 4 * g) * 2) = wv;
            } }
        }
        {
            SCAN_LANE()
            s16x8 vf[2];
#pragma unroll
            for (int ks = 0; ks < 2; ++ks) vf[ks] = cat(vtr(lds + VT + (32 * ks + 8 * g + q4) * 272 + (16 * w + 4 * p4) * 2), vtr(lds + VT + (32 * ks + 8 * g + 4 + q4) * 272 + (16 * w + 4 * p4) * 2));
            if (PB) {
#pragma unroll
                for (int ks = 0; ks < NKS; ++ks) {
                    const f32x4 e0 = *(const LAS f32x4*)(vecb + (32 * ks + 4 * g) * 4), e1 = *(const LAS f32x4*)(vecb + (32 * ks + 16 + 4 * g) * 4);
                    const f32x4 s0 = S[2 * ks] * e0, s1 = S[2 * ks + 1] * e1;
                    const v2u lo = pack4(s0[0], s0[1], s0[2], s0[3]), hi = pack4(s1[0], s1[1], s1[2], s1[3]);
                    const s16x8 bS = __builtin_bit_cast(s16x8, (v4u){lo.x, lo.y, hi.x, hi.y});
#pragma unroll
                    for (int tm = 0; tm < 4; ++tm) { const LAS unsigned char* qp = lds + QT + (16 * tm + c16) * RS + (32 * ks + 4 * g) * 2;
                        const v2u a0 = *(const LAS v2u*)qp, a1 = *(const LAS v2u*)(qp + 32);
                        o[tm] = mma(__builtin_bit_cast(s16x8, (v4u){a0.x, a0.y, a1.x, a1.y}), bS, o[tm]); }
                }
            }
#pragma unroll
            for (int dt = 0; dt < NDT; ++dt) {
                f32x4 U = (f32x4){0.f, 0.f, 0.f, 0.f};
#pragma unroll
                for (int ks = 0; ks < 2; ++ks) U = mma(cat(vtr(lds + KT + (32 * ks + 8 * g + q4) * RS + (16 * dt + 4 * p4) * 2), vtr(lds + KT + (32 * ks + 8 * g + 4 + q4) * RS + (16 * dt + 4 * p4) * 2)), vf[ks], U);
                const f32x4 el = *(const LAS f32x4*)(vecb + 512 + (16 * dt + 4 * g) * 4);
                if (PB) { const f32x4 elr = *(const LAS f32x4*)(vecb + 1024 + (16 * dt + 4 * g) * 4); S[dt] = el * S[dt] + elr * U; }
                else S[dt] = el * S[dt] + U;
            }
            if (PB) {
                __syncthreads();
#pragma unroll
                for (int tm = 0; tm < 4; ++tm)
#pragma unroll
                    for (int ks = 0; ks <= (tm >> 1); ++ks) o[tm] = mma(*(const LAS s16x8*)(lds + AT + (16 * tm + c16) * 144 + (32 * ks + 8 * g) * 2), vf[ks], o[tm]);
            }
        }
        if (PB) {
            SCAN_LANE()
            if (dir == 0) {
#pragma unroll
                for (int tm = 0; tm < 4; ++tm)
#pragma unroll
                    for (int e = 0; e < 4; ++e) OFf[(unsigned)(SCAN_TOK(stp, 4 * g) * D + SCAN_YCOL + (16 * tm + e) * D)] = o[tm][e];
                if (ci == 3) VM_WAIT();
                __syncthreads();
            } else {
#pragma unroll
                for (int tm = 0; tm < 4; ++tm) { f32x4 sq = o[tm] * o[tm];
#pragma unroll
                    for (int e = 0; e < 4; ++e) sq[e] = row16_sum(sq[e]);
                    if (c16 == 0) {
#pragma unroll
                        for (int e = 0; e < 4; ++e) *(LAS float*)(lds + HN + ((16 * tm + 4 * g + e) * 8 + w) * 4) = sq[e]; }
                }
                __syncthreads();
                const float wv = onw[16 * w + c16];
#pragma unroll
                for (int tm = 0; tm < 4; ++tm) { asm volatile("" ::: "memory");
#pragma unroll
                    for (int e = 0; e < 4; ++e) { const int tau = 16 * tm + 4 * g + e; const f32x4 h0 = *(const LAS f32x4*)(lds + HN + tau * 32), h1 = *(const LAS f32x4*)(lds + HN + tau * 32 + 16);
                        const float tot = ((h0[0] + h0[1]) + (h0[2] + h0[3])) + ((h1[0] + h1[1]) + (h1[2] + h1[3])); const float rn = rsqrtf(tot * (1.0f / 128.0f) + HEAD_EPS);
                        Y[(unsigned)(SCAN_TOK(stp, 4 * g) * D + SCAN_YCOL - (16 * tm + e) * D)] = (bf16)pg8::cvt_pk_bf16(o[tm][e] * rn * wv * bf1(gate[tm * 4 + e]), 0.f); } }
            }
        } else {
            if (ci == 3) {
                SCAN_LANE()
#pragma unroll
                for (int dt = 0; dt < NDT; ++dt) Ebuf[e_index(unit, dir, w, NDT, dt, lane0)] = S[dt];
                if (c16 == 0 && (HG || (w & 1) == 0)) *(f32x4*)(Dbuf + d_index(HG ? 1 : 0, seq, dir, seg, 16 * cdt + 4 * g)) = (f32x4){EX2(dlog[0]), EX2(dlog[1]), EX2(dlog[2]), EX2(dlog[3])};
            }
            __syncthreads();
        }
    }
#undef SCAN_LANE
#undef SCAN_GATEC
#undef SCAN_YCOL
#undef SCAN_TOK
#undef SCAN_ISSUE
#undef SCAN_WRITE
}
}

#define WSP(T, off) ((T*)(A->ws + (off)))
#define FILLER(U_, lo_, hi_) do { int rem_ = opq_s(U_) % G; if (2 * (G - rem_) < G) rem_ = 0;     \
    if (rem_ == 0 || bx >= rem_) { const int P_ = rem_ == 0 ? G : G - rem_, r_ = rem_ == 0 ? bx : bx - rem_; \
        convert_descs(A, (lo_), (hi_), r_ * NWAVES + wave, P_ * NWAVES, (LAS float*)(lds + RING_OFF + wave * 16384), lane); } } while (0)
#define PP_TAIL(U_) do { int rem_ = opq_s(U_) % G; if (2 * (G - rem_) < G) rem_ = 0; if (rem_ == 0 || bx >= rem_) { const int P_ = rem_ == 0 ? G : G - rem_, r_ = rem_ == 0 ? bx : bx - rem_; \
        pg8::Gemm gp_{WSP(bf16, WS_PB) + (size_t)layer * M * PLE, WSP(bf16, WS_WPP) + (size_t)layer * D * PLE, PLE}; pg8::StaticOrder Sp_; Sp_.init(M, D, P_, r_); EpiBf16Plain Ep_{WSP(bf16, WS_PP)}; \
        pg8::gemm_phase<EpiBf16Plain, pg8::StaticOrder, true, true>(lds + RING_OFF, gp_, Sp_, Ep_, wave); } } while (0)
#define SSP(site) (WSP(float, WS_SSP) + (size_t)((site) % 3) * M * 16)
#define PH_LOCALS KArgs A = kargs(); const int G = opq_s(gridDim.x), bx = opq_s(blockIdx.x), wave = opq_s(wave_s), lane = lane_id(), tid = wave * 64 + lane; const int vcu = (G % 8 == 0) ? (bx % 8) * (G / 8) + bx / 8 : bx; const int gw = vcu * NWAVES + wave, NGW = G * NWAVES; (void)A; (void)lane; (void)gw; (void)NGW; (void)tid;
__global__ void __launch_bounds__(NWAVES * 64, 2) mk_fwd(Args args_unused) {
    extern __shared__ __attribute__((aligned(16))) unsigned char lds_raw[];
    LAS unsigned char* lds = (LAS unsigned char*)lds_raw;
    for (int u = threadIdx.x; u < (LDS_BYTES - LDSCTL_OFF) / 4; u += NWAVES * 64) ((LAS unsigned*)(lds + LDSCTL_OFF))[u] = 0u;
    __syncthreads();
    const int wave_s = __builtin_amdgcn_readfirstlane(threadIdx.x >> 6);
    int lo, hi;
    { KArgs A = kargs(); lo = A->ph_lo; hi = A->ph_hi;
#if !MK_MULTI
      (void)xcd_barrier_post(WSP(unsigned, WS_CTL) + CW_BAR, (volatile LAS unsigned*)(lds + MISC_OFF) + 8);
#endif
    }
    int ph = 0;
#define IN_PH (lo <= ph && ph < hi)
#if MK_MULTI
#define SEAM do { ++ph; } while (0)
#else
#define SEAM do { if (lo <= ph && ph + 1 < hi) { KArgs A_ = kargs(); XcdBarrier bar_; bar_.bar = (unsigned*)(A_->ws + WS_CTL) + CW_BAR; bar_.x = xb_xcc_id(); bar_.st = (volatile LAS unsigned*)(lds + MISC_OFF) + 8; xcd_barrier(bar_); } ++ph; } while (0)
#endif

    for (int rep = 0; rep < REP_PRO; ++rep) { if (rep) --ph;
    if (IN_PH) {
        PH_LOCALS
        bf16* HB = WSP(bf16, WS_HBX); float* SS = SSP(0); float* lbt = WSP(float, WS_TAB + TAB_LB);
        LAS float* scr = (LAS float*)(lds + RING_OFF + wave * 16384);
        convert_descs(A, 0, 10, gw, NGW, scr, lane);
        convert_descs(A, 20, 23, gw, NGW, scr, lane);
        for (int it = gw; it < 8 * 16 * 8; it += NGW) { const int mat = it / 128, kb = (it % 128) / 8, nb = it % 8, i = mat >> 1, dd = mat & 1, k0 = 64 * kb, n = 32 * nb + (lane & 31);
            const float* wl = A->in[I_WIN] + (size_t)i * D * DIN + 1536 + 16 * dd; const float* g2 = A->in[I_WG2] + (size_t)(i * 2 + dd) * 16 * 256 + n; const float* nm = A->in[I_NMIX] + i * D;
            LAS float* wls = scr + 64 * 33;
            { const f32x4* wr4 = (const f32x4*)(wl + (size_t)(k0 + lane) * DIN); const f32x4 w0 = wr4[0], w1 = wr4[1], w2 = wr4[2], w3 = wr4[3]; const float sc = nm[k0 + lane];
              LAS f32x4* d4 = (LAS f32x4*)(wls + lane * 20); d4[0] = w0 * sc; d4[1] = w1 * sc; d4[2] = w2 * sc; d4[3] = w3 * sc; }
            float gr[16];
#pragma unroll
            for (int r = 0; r < 16; ++r) gr[r] = g2[r * 256];
            LDS_WAIT(); asm volatile("" ::: "memory");
#pragma unroll 4
            for (int q = 0; q < 32; ++q) { const int kk = 2 * q + (lane >> 5); const LAS f32x4* w4 = (const LAS f32x4*)(wls + kk * 20); const f32x4 a0 = w4[0], a1 = w4[1], a2 = w4[2], a3 = w4[3];
                float s = (a0[0] * gr[0] + a0[1] * gr[1]) + (a0[2] * gr[2] + a0[3] * gr[3]); s += (a1[0] * gr[4] + a1[1] * gr[5]) + (a1[2] * gr[6] + a1[3] * gr[7]);
                s += (a2[0] * gr[8] + a2[1] * gr[9]) + (a2[2] * gr[10] + a2[3] * gr[11]); s += (a3[0] * gr[12] + a3[1] * gr[13]) + (a3[2] * gr[14] + a3[3] * gr[15]);
                scr[kk * 33 + (lane & 31)] = s; }
            tr_writeout(WSP(bf16, WS_WIN) + (size_t)i * NPROJ * D, D, 4096 + 256 * dd + 32 * nb, k0, scr, lane);
        }
        for (int m = gw; m < M; m += NGW) { const f32x4* xr = (const f32x4*)(A->in[I_X] + (size_t)m * D) + lane; v2u* br = (v2u*)(HB + (size_t)m * D) + lane; float s = 0.f;
#pragma unroll
            for (int j = 0; j < 4; ++j) { const f32x4 v = xr[64 * j]; v2u w; w.x = pk2(v[0], v[1]); w.y = pk2(v[2], v[3]); br[64 * j] = w; const float r0 = bflo(w.x), r1 = bfhi(w.x), r2 = bflo(w.y), r3 = bfhi(w.y); s += (r0 * r0 + r1 * r1) + (r2 * r2 + r3 * r3); }
            s = wave_sum(s); if (lane < 16) SS[(size_t)m * 16 + lane] = lane == 0 ? s : 0.f; }
        { const size_t n4 = (size_t)DEPTH * M * PLE / 4; const f32x4* src = (const f32x4*)A->in[I_P]; v2u* dst = WSP(v2u, WS_PB);
          for (size_t i = (size_t)bx * 512 + tid; i < n4; i += (size_t)G * 512) { const f32x4 v = src[i]; v2u w; w.x = pk2(v[0], v[1]); w.y = pk2(v[2], v[3]); dst[i] = w; } }
        for (int i = bx * 512 + tid; i < 1024; i += G * 512) { const float* l = A->in[I_LBL]; float z0 = l[i], z1 = l[1024 + i], z2 = l[2048 + i], z3 = l[3072 + i];
            const float mx = fmaxf(fmaxf(z0, z1), fmaxf(z2, z3)); z0 = __expf(z0 - mx); z1 = __expf(z1 - mx); z2 = __expf(z2 - mx); z3 = __expf(z3 - mx);
            const float inv = 1.0f / (z0 + z1 + z2 + z3);
            lbt[i] = 0.f; lbt[1024 + i] = z1 * inv; lbt[2048 + i] = (z1 + z2) * inv; lbt[3072 + i] = (z1 + z2 + z3) * inv; }
    }
    SEAM; }

    for (int layer = 0; layer < DEPTH; ++layer) {
        for (int rep = 0; rep < REP_G1; ++rep) { if (rep) --ph;
        if (IN_PH) {
            PH_LOCALS
            pg8::Gemm g{WSP(bf16, WS_HBX), WSP(bf16, WS_WIN) + (size_t)layer * NPROJ * D, D}; pg8::StaticOrder S; S.init(M, NPROJ, G, bx);
            EpiProj E{WSP(bf16, WS_BIG), SSP(layer * 3), WSP(float, WS_TAB + TAB_LB) + layer * 1024, A->in[I_BG] + layer * 512};
            pg8::gemm_phase<EpiProj, pg8::StaticOrder, true, true>(lds + RING_OFF, g, S, E, wave);
            if (rep == 0 && layer == 0) FILLER(S.nwg, 26, 34);
            if (rep == 0 && layer == 1) FILLER(S.nwg, 42, 50);
        }
        SEAM; }
        for (int rep = 0; rep < REP_SCAN; ++rep) { if (rep) ph -= 3;
        if (IN_PH) {
            PH_LOCALS
            for (int unit = bx; unit < 256; unit += G) {
                scan::scan_unit<64, false, false>(WSP(bf16, WS_BIG), nullptr, WSP(f32x4, WS_XG + scan::E_G_OFF), WSP(float, WS_XG + scan::D_OFF), nullptr, nullptr, unit, lds, wave, lane);
                scan::scan_unit<128, true, false>(WSP(bf16, WS_BIG), nullptr, WSP(f32x4, WS_XG + scan::E_H_OFF), WSP(float, WS_XG + scan::D_OFF), nullptr, nullptr, unit, lds, wave, lane);
            }
        }
        SEAM;
        if (IN_PH) {
            PH_LOCALS
            const float* Db = WSP(float, WS_XG + scan::D_OFF);
            for (int gt = bx * 512 + tid; gt < 32768 + 65536; gt += G * 512) {
                const bool hg = gt >= 32768; const int r = hg ? gt - 32768 : gt, ndt = hg ? 8 : 4, ln = r & 63; int x = r >> 6; const int dt = x % ndt; x /= ndt; const int w = x & 7; x >>= 3; const int dir = x & 1, seq = x >> 1;
                f32x4* E = hg ? WSP(f32x4, WS_XG + scan::E_H_OFF) : WSP(f32x4, WS_XG + scan::E_G_OFF);
                f32x4 carry = (f32x4){0.f, 0.f, 0.f, 0.f};
                for (int i0 = 0; i0 < 32; i0 += 8) {
                    f32x4 e8[8], d8[8];
#pragma unroll
                    for (int j = 0; j < 8; ++j) { const int seg = dir ? 31 - (i0 + j) : (i0 + j); e8[j] = E[scan::e_index(seq * 32 + seg, dir, w, ndt, dt, ln)]; d8[j] = *(const f32x4*)(Db + scan::d_index(hg ? 1 : 0, seq, dir, seg, 16 * dt + 4 * (ln >> 4))); }
#pragma unroll
                    for (int j = 0; j < 8; ++j) { const int seg = dir ? 31 - (i0 + j) : (i0 + j); E[scan::e_index(seq * 32 + seg, dir, w, ndt, dt, ln)] = carry; carry = d8[j] * carry + e8[j]; }
                }
            }
        }
        SEAM;
        if (IN_PH) {
            PH_LOCALS
            for (int unit = bx; unit < 256; unit += G) {
                scan::scan_unit<64, false, true>(WSP(bf16, WS_BIG), WSP(float, WS_YS), WSP(f32x4, WS_XG + scan::E_G_OFF), nullptr, WSP(bf16, WS_Y), A->in[I_GON] + layer * 128, unit, lds, wave, lane);
                scan::scan_unit<128, true, true>(WSP(bf16, WS_BIG), WSP(float, WS_YS), WSP(f32x4, WS_XG + scan::E_H_OFF), nullptr, WSP(bf16, WS_Y), A->in[I_HON] + layer * 128, unit, lds, wave, lane);
            }
        }
        SEAM; }
        if (IN_PH) {
            PH_LOCALS
            pg8::Gemm g{WSP(bf16, WS_Y), WSP(bf16, WS_WOUT) + (size_t)layer * D * D, D}; pg8::StaticOrder S; S.init(M, D, G, bx);
            EpiRes<0> E{WSP(bf16, WS_HBX), WSP(bf16, WS_HB), SSP(layer * 3 + 1), nullptr, nullptr, WSP(unsigned char, WS_HQ), 1.0f};
            pg8::gemm_phase<EpiRes<0>, pg8::StaticOrder, true, true>(lds + RING_OFF, g, S, E, wave);
        }
        SEAM;
        if ((layer & 1) == 0) {
            for (int rep = 0; rep < REP_G3; ++rep) { if (rep) --ph;
            if (IN_PH) {
                PH_LOCALS
                #if F8_DENSE
                pg8::Gemm g{WSP(bf16, WS_HQ), (bf16*)(WSP(unsigned char, WS_WGU) + (size_t)(layer >> 1) * 2 * FFD * D), D / 2}; pg8::StaticOrder S; S.init(M, 2 * FFD, G, bx);
                EpiSwiGLU<true> E{WSP(bf16, WS_BIG), FFD, SSP(layer * 3 + 1), nullptr, 1.0f / F8_GMUL};
                pg8::gemm_phase<EpiSwiGLU<true>, pg8::StaticOrder, true, true, false, true>(lds + RING_OFF, g, S, E, wave);
#else
                pg8::Gemm g{WSP(bf16, WS_HB), WSP(bf16, WS_WGU) + (size_t)(layer >> 1) * 2 * FFD * D, D}; pg8::StaticOrder S; S.init(M, 2 * FFD, G, bx);
                EpiSwiGLU<(F8_DDN != 0)> E{WSP(bf16, WS_BIG), FFD, SSP(layer * 3 + 1), nullptr, 1.0f};
                pg8::gemm_phase<EpiSwiGLU<(F8_DDN != 0)>, pg8::StaticOrder, true, true>(lds + RING_OFF, g, S, E, wave);
#endif
                if (rep == 0 && layer == 0) FILLER(S.nwg, 34, 42);
                if (rep == 0 && layer >= 2) PP_TAIL(S.nwg);
            }
            SEAM; }
            if (IN_PH) {
                PH_LOCALS
                #if F8_DENSE || F8_DDN
                pg8::Gemm g{WSP(bf16, WS_BIG), (bf16*)(WSP(unsigned char, WS_WDN) + (size_t)(layer >> 1) * D * FFD), FFD / 2}; pg8::StaticOrder S; S.init(M, D, G, bx);
                EpiRes<0> E{WSP(bf16, WS_HB), WSP(bf16, WS_HB), SSP(layer * 3 + 2), nullptr, nullptr, nullptr, 1.0f / (F8_WMUL * F8_AMUL)};
                pg8::gemm_phase<EpiRes<0>, pg8::StaticOrder, true, true, false, true>(lds + RING_OFF, g, S, E, wave);
#else
                pg8::Gemm g{WSP(bf16, WS_BIG), WSP(bf16, WS_WDN) + (size_t)(layer >> 1) * D * FFD, FFD}; pg8::StaticOrder S; S.init(M, D, G, bx);
                EpiRes<0> E{WSP(bf16, WS_HB), WSP(bf16, WS_HB), SSP(layer * 3 + 2), nullptr, nullptr, nullptr, 1.0f};
                pg8::gemm_phase<EpiRes<0>, pg8::StaticOrder, true, true>(lds + RING_OFF, g, S, E, wave);
#endif
            }
            SEAM;
            ph += 3;
        } else {
            if (IN_PH) {
                PH_LOCALS
                const bf16* hb = WSP(bf16, WS_HB); unsigned* cnt = WSP(unsigned, WS_CTL) + CW_CNT + (layer >> 1) * 8 * 64;
                int* ltok = WSP(int, WS_TAB + TAB_LTOK); float* lw = WSP(float, WS_TAB + TAB_LW); float* rstd_tok = WSP(float, WS_TAB + TAB_RSTD);
                LAS float* wrs = (LAS float*)lds;
                const float* wrt = A->in[I_WR] + (size_t)(layer >> 1) * D * NEXP; const float* nf = A->in[I_NFFN] + layer * D;
                for (int idx = tid; idx < D * NEXP; idx += 512) wrs[idx] = wrt[idx] * nf[idx >> 3];
                __syncthreads();
                for (int m = gw; m < M; m += NGW) {
                    const v2u* hr = (const v2u*)(hb + (size_t)m * D) + lane; f32x4 v[4]; float s = 0.f;
#pragma unroll
                    for (int q = 0; q < 4; ++q) { const v2u hw = hr[64 * q]; v[q] = (f32x4){bflo(hw.x), bfhi(hw.x), bflo(hw.y), bfhi(hw.y)}; s += (v[q][0] * v[q][0] + v[q][1] * v[q][1]) + (v[q][2] * v[q][2] + v[q][3] * v[q][3]); }
                    const float rs = rsqrtf(wave_sum(s) * (1.0f / 1024.0f) + EPS);
                    float lg[8];
#pragma unroll
                    for (int e = 0; e < 8; ++e) lg[e] = 0.f;
#pragma unroll
                    for (int q = 0; q < 4; ++q)
#pragma unroll
                        for (int c = 0; c < 4; ++c) { const int k = 256 * q + 4 * lane + c; const f32x4 w0 = *(const LAS f32x4*)(wrs + k * 8), w1 = *(const LAS f32x4*)(wrs + k * 8 + 4); const float x = v[q][c];
                            lg[0] += x * w0[0]; lg[1] += x * w0[1]; lg[2] += x * w0[2]; lg[3] += x * w0[3]; lg[4] += x * w1[0]; lg[5] += x * w1[1]; lg[6] += x * w1[2]; lg[7] += x * w1[3]; }
                    float mx = -1e30f;
#pragma unroll
                    for (int e = 0; e < 8; ++e) { lg[e] = wave_sum(lg[e]) * rs; mx = fmaxf(mx, lg[e]); }
                    float pe[8];
#pragma unroll
                    for (int e = 0; e < 8; ++e) pe[e] = __expf(lg[e] - mx);
                    int i1 = 0; float p1 = pe[0];
#pragma unroll
                    for (int e = 1; e < 8; ++e) if (pe[e] > p1) { p1 = pe[e]; i1 = e; }
                    int i2 = 0; float p2 = -1.f;
#pragma unroll
                    for (int e = 0; e < 8; ++e) if (e != i1 && pe[e] > p2) { p2 = pe[e]; i2 = e; }
                    if (lane == 0) { const float w1 = p1 / (p1 + p2), w2 = p2 / (p1 + p2);
                        const unsigned q1 = __hip_atomic_fetch_add(cnt + 64 * i1, 1u, RLX_AGENT), q2 = __hip_atomic_fetch_add(cnt + 64 * i2, 1u, RLX_AGENT);
                        ltok[i1 * M + q1] = m; lw[i1 * M + q1] = w1; ltok[i2 * M + q2] = m | (1 << 16); lw[i2 * M + q2] = w2; rstd_tok[m] = rs; }
                }
            }
            SEAM;
            if (IN_PH) {
                PH_LOCALS
                unsigned* cnt = WSP(unsigned, WS_CTL) + CW_CNT + (layer >> 1) * 8 * 64;
                const int* ltok = WSP(int, WS_TAB + TAB_LTOK); const float* lw = WSP(float, WS_TAB + TAB_LW); const float* rstd_tok = WSP(float, WS_TAB + TAB_RSTD);
                int2* rinfo = WSP(int2, WS_TAB + TAB_RINFO); float* rrstd = WSP(float, WS_TAB + TAB_RRSTD); int* rowtok = WSP(int, WS_TAB + TAB_ROWTOK);
                unsigned cn[8], tb[8]; unsigned t = 0;
#pragma unroll
                for (int e = 0; e < 8; ++e) { cn[e] = __hip_atomic_load(cnt + 64 * e, RLX_AGENT); tb[e] = t; t += (cn[e] + 255u) >> 8; }
                const int total = (int)t * 256;
                for (int R = bx * 512 + tid; R < total; R += G * 512) { const unsigned tile = (unsigned)R >> 8; unsigned ce = 0, te = 0; int es = 0;
#pragma unroll
                    for (int e = 0; e < 8; ++e) if (tile >= tb[e]) { ce = cn[e]; te = tb[e]; es = e; }
                    const unsigned pos = (unsigned)R - te * 256u; const bool valid = pos < ce; const unsigned pc = valid ? pos : 0u;
                    const int tr = ltok[es * M + pc]; const int tok = valid ? (tr & 0xffff) : 0; const float wv = lw[es * M + pc], rv = rstd_tok[tok];
                    rinfo[R] = make_int2(valid ? tr : (int)(0x80000000u | pos), valid ? __float_as_int(wv) : 0); rrstd[R] = valid ? rv : 0.f; rowtok[R] = tok;
                }
            }
            SEAM;
            for (int rep = 0; rep < REP_G5; ++rep) { if (rep) --ph;
            if (IN_PH) {
                PH_LOCALS
                #if F8_EGU
                pg8::Gemm g{WSP(bf16, WS_HQ), (bf16*)(WSP(unsigned char, WS_WEGU) + (size_t)(layer >> 1) * 8 * 2 * FFE * D), D / 2, WSP(int, WS_TAB + TAB_ROWTOK)};
#else
                pg8::Gemm g{WSP(bf16, WS_HB), WSP(bf16, WS_WEGU) + (size_t)(layer >> 1) * 8 * 2 * FFE * D, D, WSP(int, WS_TAB + TAB_ROWTOK)};
#endif
                pg8::GroupedOrder S; S.init(WSP(unsigned, WS_CTL) + CW_CNT + (layer >> 1) * 8 * 64, 2 * FFE / 256, G, bx);
                #if F8_EGU
                EpiSwiGLU<true> E{WSP(bf16, WS_BIG), FFE, nullptr, WSP(float, WS_TAB + TAB_RRSTD), 1.0f / F8_GMUL};
                pg8::gemm_phase<EpiSwiGLU<true>, pg8::GroupedOrder, true, true, true, true>(lds + RING_OFF, g, S, E, wave);
#else
                EpiSwiGLU<true> E{WSP(bf16, WS_BIG), FFE, nullptr, WSP(float, WS_TAB + TAB_RRSTD), 1.0f};
                pg8::gemm_phase<EpiSwiGLU<true>, pg8::GroupedOrder, true, true, true, false>(lds + RING_OFF, g, S, E, wave);
#endif
                if (rep == 0 && layer == 1) { FILLER(S.U, 10, 20); FILLER(S.U, 23, 26); }
                if (rep == 0 && layer >= 2) PP_TAIL(S.U);
            }
            SEAM; }
            if (IN_PH) {
                PH_LOCALS
                pg8::Gemm g{WSP(bf16, WS_BIG), (bf16*)(WSP(unsigned char, WS_WEDN) + (size_t)(layer >> 1) * 8 * D * FFE), FFE / 2}; pg8::GroupedOrder S; S.init(WSP(unsigned, WS_CTL) + CW_CNT + (layer >> 1) * 8 * 64, D / 256, G, bx);
                EpiScatter E{WSP(bf16, WS_YS), WSP(int2, WS_TAB + TAB_RINFO)};
                pg8::gemm_phase<EpiScatter, pg8::GroupedOrder, true, true, false, true>(lds + RING_OFF, g, S, E, wave);
                if (layer == 1) FILLER(S.U, ND_PRO, ND);
            }
            SEAM;
            if (IN_PH) {
                PH_LOCALS
                const bf16* YS = WSP(bf16, WS_YS); bf16* HB = WSP(bf16, WS_HB); float* ss_ple = SSP(layer * 3 + 2);
                for (int m = gw; m < M; m += NGW) { const v2u* y0 = (const v2u*)(YS + (size_t)m * D) + lane; const v2u* y1 = (const v2u*)(YS + (size_t)(M + m) * D) + lane;
                    v2u* br = (v2u*)(HB + (size_t)m * D) + lane; float s = 0.f;
#pragma unroll
                    for (int q = 0; q < 4; ++q) { const v2u hw = br[64 * q], a = y0[64 * q], b = y1[64 * q];
                        v2u w; w.x = pg8::cvt_pk_bf16(bflo(hw.x) + (bflo(a.x) + bflo(b.x)), bfhi(hw.x) + (bfhi(a.x) + bfhi(b.x))); w.y = pg8::cvt_pk_bf16(bflo(hw.y) + (bflo(a.y) + bflo(b.y)), bfhi(hw.y) + (bfhi(a.y) + bfhi(b.y)));
                        br[64 * q] = w; const float r0 = bflo(w.x), r1 = bfhi(w.x), r2 = bflo(w.y), r3 = bfhi(w.y); s += (r0 * r0 + r1 * r1) + (r2 * r2 + r3 * r3); }
                    s = wave_sum(s); if (lane < 16) ss_ple[(size_t)m * 16 + lane] = lane == 0 ? s : 0.f; }
            }
            SEAM;
        }
        if (IN_PH) {
            if (layer < 2) { PH_LOCALS
              pg8::Gemm g{WSP(bf16, WS_PB) + (size_t)layer * M * PLE, WSP(bf16, WS_WPP) + (size_t)layer * D * PLE, PLE}; pg8::StaticOrder S; S.init(M, D, G, bx);
              EpiBf16Plain E{WSP(bf16, WS_PP)};
              pg8::gemm_phase<EpiBf16Plain, pg8::StaticOrder, true, true>(lds + RING_OFF, g, S, E, wave); }
            VM_WAIT(); __syncthreads();
            { PH_LOCALS
              pg8::Gemm g{WSP(bf16, WS_HB), WSP(bf16, WS_WPG) + (size_t)layer * D * D, D}; pg8::StaticOrder S; S.init(M, D, G, bx);
              EpiRes<1> E{WSP(bf16, WS_HB), WSP(bf16, WS_HBX), SSP(layer * 3 + 3), SSP(layer * 3 + 2), WSP(bf16, WS_PP), nullptr, 1.0f};
              pg8::gemm_phase<EpiRes<1>, pg8::StaticOrder, true, true>(lds + RING_OFF, g, S, E, wave); }
        }
        SEAM;
    }
    if (IN_PH) {
        PH_LOCALS
        float* out = A->out; const bf16* hb = WSP(bf16, WS_HBX); const float* ssf = SSP(12); const f32x4* nw = (const f32x4*)A->in[I_NFIN] + lane;
        for (int m = gw; m < M; m += NGW) { const v2u* hr = (const v2u*)(hb + (size_t)m * D) + lane; f32x4* orow = (f32x4*)(out + (size_t)m * D) + lane; const float rs = rsqrtf(ss_load(ssf, m) * (1.0f / 1024.0f) + EPS);
#pragma unroll
            for (int q = 0; q < 4; ++q) { const v2u hw = hr[64 * q]; const f32x4 w = nw[64 * q]; orow[64 * q] = (f32x4){bflo(hw.x), bfhi(hw.x), bflo(hw.y), bfhi(hw.y)} * rs * w; } }
    }
#undef IN_PH
#undef SEAM
}
constexpr int PH_PER_LAYER = 11, N_PHASES = 2 + DEPTH * PH_PER_LAYER;

extern "C" void kernel_launch(void* const* d_in, const int* in_sizes, int n_in, void* d_out, int out_size, void* d_ws, size_t ws_size, hipStream_t stream) {
    static int grid = 0;
    if (grid == 0) {
        if (n_in != 22 || out_size != M * D || ws_size < WS_END) { fprintf(stderr, "kernel_launch: unexpected shapes (n_in %d, out %d, ws %zu need %zu); nothing launched\n", n_in, out_size, ws_size, (size_t)WS_END); grid = -1; return; }
        int dev = 0, cus = 0;
        if (hipGetDevice(&dev) != hipSuccess || hipDeviceGetAttribute(&cus, hipDeviceAttributeMultiprocessorCount, dev) != hipSuccess) { grid = -1; return; }
        if (hipFuncSetAttribute((const void*)mk_fwd, hipFuncAttributeMaxDynamicSharedMemorySize, LDS_BYTES) != hipSuccess) { fprintf(stderr, "kernel_launch: hipFuncSetAttribute failed\n"); grid = -1; return; }
        int per_cu = 0;
        if (hipOccupancyMaxActiveBlocksPerMultiprocessor(&per_cu, (const void*)mk_fwd, NWAVES * 64, LDS_BYTES) != hipSuccess || per_cu < 1) fprintf(stderr, "kernel_launch: occupancy query says %d\n", per_cu);
        (void)hipGetLastError();
        grid = cus;
    }
    if (grid < 0) return;
    if (hipMemsetAsync((char*)d_ws + WS_CTL, 0, CTL_ZERO_BYTES, stream) != hipSuccess) return;
    Args a{};
    for (int i = 0; i < 22; ++i) a.in[i] = (const float*)d_in[i];
    a.out = (float*)d_out; a.ws = (unsigned char*)d_ws;
#if MK_MULTI
    for (int k = 0; k < N_PHASES; ++k) {
        if (k >= 1 && k < 1 + DEPTH * PH_PER_LAYER) { const int layer = (k - 1) / PH_PER_LAYER, p = (k - 1) % PH_PER_LAYER; if ((layer & 1) == 0 && p >= 7 && p <= 9) continue; }
        a.ph_lo = k; a.ph_hi = k + 1;
        hipLaunchKernelGGL(mk_fwd, dim3(grid), dim3(NWAVES * 64), LDS_BYTES, stream, a);
    }
#else
    a.ph_lo = 0; a.ph_hi = N_PHASES;
    hipLaunchKernelGGL(mk_fwd, dim3(grid), dim3(NWAVES * 64), LDS_BYTES, stream, a);
#endif
    const hipError_t le = hipPeekAtLastError();
    if (le != hipSuccess) fprintf(stderr, "kernel_launch: launch failed: %s\n", hipGetErrorName(le));
}
```

```cpp
#include <hip/hip_runtime.h>
#include <cstdio>
#include <cstdint>

#ifndef REP_PRO
#define REP_PRO 1
#endif
#ifndef REP_G1
#define REP_G1 1
#endif
#ifndef REP_SCAN
#define REP_SCAN 1
#endif
#ifndef REP_G5
#define REP_G5 1
#endif
#ifndef MK_FLAGS
#define MK_FLAGS 6
#endif
#ifndef REP_G3
#define REP_G3 1
#endif
#ifndef MK_MULTI
#define MK_MULTI 0
#endif

namespace pg8 {
#define PG8_LAS __attribute__((address_space(3)))
typedef unsigned short bf16_t;
typedef short bf16x8 __attribute__((ext_vector_type(8)));
typedef float f32x4 __attribute__((ext_vector_type(4)));
typedef unsigned u32x4 __attribute__((ext_vector_type(4)));
typedef unsigned u32x2 __attribute__((ext_vector_type(2)));
constexpr int BM = 256, BK = 64, HALF = 128, HTB = HALF * BK * 2, STAGE_BYTES = 8 * HTB, NXCD = 8, WGM = 8;

__host__ __device__ __forceinline__ int lds_byte(int r, int c) { const int st = (r >> 4) * 2 + (c >> 5), rr = r & 15, cc = c & 31, ob = rr * 64 + cc * 2; return st * 1024 + (ob ^ (((ob >> 9) & 1) << 5)); }
__host__ __device__ __forceinline__ void stage_rc(int b, int& R, int& C) { const int st = b / 1024, sb = b % 1024, swz = sb ^ (((sb >> 9) & 1) << 5); R = (st >> 1) * 16 + swz / 64; C = (st & 1) * 32 + (swz % 64) / 2; }
__host__ __device__ __forceinline__ int perm32(int rho) { const int n = rho >> 4, i = rho & 15; return 8 * (i >> 2) + 4 * n + (i & 3); }

struct Unit { int pm, pn, pnl, ord, rbase, nvalid; };
struct Gemm { const bf16_t* A; const bf16_t* Bt; int K; const int* rowsrc; };

template <bool F8> struct FragT { typedef bf16x8 A[4][2]; typedef bf16x8 B[2][2]; };
typedef int v8i_t __attribute__((ext_vector_type(8)));
template <> struct FragT<true> { typedef v8i_t A[4]; typedef v8i_t B[2]; };
typedef int v4i_t __attribute__((ext_vector_type(4)));
__device__ __forceinline__ int xcd_remap(int wgid, int nwg) { const int q = nwg / NXCD, r = nwg % NXCD, xcd = wgid % NXCD, off = wgid / NXCD; return (xcd < r ? xcd * (q + 1) : r * (q + 1) + (xcd - r) * q) + off; }

struct StaticOrder {
    int nM, nN, nwg, G, c;
    __device__ void init(int M, int N, int G_, int c_) { nM = M / BM; nN = N / BM; nwg = nM * nN; G = G_; c = c_; }
    __device__ bool next(int i, Unit& u) const {
        const long L = (long)i * G + c; if (L >= nwg) return false;
        const int wgid = xcd_remap((int)L, nwg);
        const int nig = WGM * nN, gid = wgid / nig, fm = gid * WGM, gsz = (nM - fm) < WGM ? (nM - fm) : WGM;
        u.pm = fm + ((wgid % nig) % gsz); u.pn = (wgid % nig) / gsz; u.pnl = u.pn; u.ord = i; u.rbase = 0; u.nvalid = 256; return true;
    }
    __device__ __forceinline__ void a_ready(const Unit&) const {}
    __device__ __forceinline__ void done(const Unit&) const {}
};
struct GroupedOrder {
    unsigned cn[8], cr[8]; int nN, U, G, c, ldl;
    __device__ void init(const unsigned* cnt64, int nN_, int G_, int c_, int ldl_ = 0) {
        int t = 0;
#pragma unroll
        for (int e = 0; e < 8; ++e) { cr[e] = __hip_atomic_load(cnt64 + 64 * e, __ATOMIC_RELAXED, __HIP_MEMORY_SCOPE_AGENT); cn[e] = (cr[e] + 255u) >> 8; t += (int)cn[e]; }
        nN = nN_; U = t * nN; G = G_; c = c_; ldl = ldl_;
    }
    __device__ bool next(int i, Unit& u) const {
        const long L = (long)i * G + c; if (L >= U) return false;
        const int w0 = xcd_remap((int)L, U);
        int base = 0, tb = 0, es = 0, bs = 0, ns = 1, ts = 0, rw = 0;
#pragma unroll
        for (int e = 0; e < 8; ++e) { const int n = (int)cn[e], ue = n * nN; const bool hit = (w0 >= base) && (w0 < base + ue); if (hit) { es = e; bs = base; ns = n; ts = tb; rw = (int)cr[e]; } base += ue; tb += n; }
        const int w = w0 - bs, nig = WGM * nN, gid = w / nig, fm = gid * WGM, gsz = (ns - fm) < WGM ? (ns - fm) : WGM;
        const int tl = fm + ((w % nig) % gsz);
        u.pm = ts + tl; u.pnl = (w % nig) / gsz; u.pn = es * nN + u.pnl; u.ord = i; u.rbase = es * ldl + tl * 256; u.nvalid = (rw - tl * 256) < 256 ? (rw - tl * 256) : 256; return true;
    }
    __device__ __forceinline__ void a_ready(const Unit&) const {}
    __device__ __forceinline__ void done(const Unit&) const {}
};

typedef float f32x2_t __attribute__((ext_vector_type(2)));
typedef __bf16 bf16x2_t __attribute__((ext_vector_type(2)));
__device__ __forceinline__ unsigned cvt_pk_bf16(float lo, float hi) { const f32x2_t v = {lo, hi}; const bf16x2_t b = __builtin_convertvector(v, bf16x2_t); return __builtin_bit_cast(unsigned, b); }

template <class Epi, class Sched, bool ALIGN_EPI = false, bool SP2 = false, bool GATHER = false, bool FP8 = false>
__device__ __forceinline__ void gemm_phase(PG8_LAS unsigned char* lds, const Gemm g, const Sched& S, const Epi& E, int wid_s) {
    int lane_; asm volatile("v_mbcnt_lo_u32_b32 %0, -1, 0\n\tv_mbcnt_hi_u32_b32 %0, -1, %0" : "=v"(lane_));
    const int wid = wid_s, lane = lane_, tid = wid * 64 + lane, wr = wid >> 2, wc = wid & 3, fr = lane & 15, fq = lane >> 4;
    const int K = g.K, nt = K / BK;
    unsigned voffA[2], voffB[2]; int gR[2]; unsigned gC[2];
#pragma unroll
    for (int i = 0; i < 2; ++i) { int R, C; stage_rc(tid * 16 + i * 8192, R, C); const int Rb = Epi::PERM ? ((R & ~31) + perm32(R & 31)) : R;
        voffA[i] = (unsigned)(R * K + C) * 2u; voffB[i] = (unsigned)(Rb * K + C) * 2u; gR[i] = R; gC[i] = (unsigned)C * 2u; }
    unsigned gvc[2][2], gvn[2][2];
#define PG8_GOFF(dst, un) do { if constexpr (GATHER) { _Pragma("unroll") for (int h_ = 0; h_ < 2; ++h_) _Pragma("unroll") for (int i_ = 0; i_ < 2; ++i_) \
        { const int r_ = h_ * HALF + gR[i_]; dst[h_][i_] = (unsigned)(g.rowsrc[(un).rbase + (r_ < (un).nvalid ? r_ : (un).nvalid - 1)] & 0xffff) * (unsigned)(K * 2) + gC[i_]; } } } while (0)
#define PG8_STAGE_A(bufoff, nextu, h, kbyte) do { if constexpr (GATHER) { _Pragma("unroll") for (int _i = 0; _i < 2; ++_i) \
        __builtin_amdgcn_global_load_lds((const unsigned*)((const char*)g.A + (size_t)(kbyte) + ((nextu) ? gvn[h][_i] : gvc[h][_i])), (PG8_LAS unsigned*)(lds + (bufoff) + ldsw + _i * 8192), 16, 0, 0); } \
        else { PG8_STAGE(bufoff, ((nextu) ? nA : cA) + (size_t)(h) * hstep + (size_t)(kbyte), voffA); } } while (0)
    const size_t kstep = (size_t)(BK * 2);
    const size_t hstep = (size_t)HALF * K * 2;
    const size_t tstep = 2 * hstep;
    const unsigned ldsw = (unsigned)wid * 1024u;
    const int aoff = FP8 ? lds_byte(wr * 64 + fr, fq * 16) : lds_byte(wr * 64 + fr, fq * 8), boff = FP8 ? lds_byte(wc * 32 + fr, fq * 16) : lds_byte(wc * 32 + fr, fq * 8);
#define PG8_SA(b, h) (((b) * 2 + (h)) * HTB)
#define PG8_SB(b, h) ((4 + (b) * 2 + (h)) * HTB)
#define PG8_STAGE(bufoff, gbase, voff) do { _Pragma("unroll") for (int _i = 0; _i < 2; ++_i) \
        __builtin_amdgcn_global_load_lds((const unsigned*)((const char*)(gbase) + (voff)[_i]), (PG8_LAS unsigned*)(lds + (bufoff) + ldsw + _i * 8192), 16, 0, 0); } while (0)
#define PG8_LDA(dst, b, h) do { if constexpr (FP8) { _Pragma("unroll") for (int m = 0; m < 4; ++m) { const PG8_LAS v4i_t* p_ = (const PG8_LAS v4i_t*)(lds + PG8_SA(b, h) + aoff + m * 2048); dst[m] = __builtin_shufflevector(p_[0], p_[1], 0, 1, 2, 3, 4, 5, 6, 7); } } \
        else { _Pragma("unroll") for (int m = 0; m < 4; ++m) _Pragma("unroll") for (int k = 0; k < 2; ++k) dst[m][k] = *(const PG8_LAS bf16x8*)(lds + PG8_SA(b, h) + aoff + m * 2048 + k * 1024); } } while (0)
#define PG8_LDB(dst, b, h) do { if constexpr (FP8) { _Pragma("unroll") for (int n = 0; n < 2; ++n) { const PG8_LAS v4i_t* p_ = (const PG8_LAS v4i_t*)(lds + PG8_SB(b, h) + boff + n * 2048); dst[n] = __builtin_shufflevector(p_[0], p_[1], 0, 1, 2, 3, 4, 5, 6, 7); } } \
        else { _Pragma("unroll") for (int n = 0; n < 2; ++n) _Pragma("unroll") for (int k = 0; k < 2; ++k) dst[n][k] = *(const PG8_LAS bf16x8*)(lds + PG8_SB(b, h) + boff + n * 2048 + k * 1024); } } while (0)
#define PG8_MMA(ai, bj, At, Bt) do { __builtin_amdgcn_s_setprio(1); _Pragma("unroll") for (int m = 0; m < 4; ++m) _Pragma("unroll") for (int n = 0; n < 2; ++n) { \
        if constexpr (FP8) asm volatile("v_mfma_scale_f32_16x16x128_f8f6f4 %0, %1, %2, %0, %3, %3 op_sel_hi:[0,0,0]" : "+v"(acc[ai][bj][m][n]) : "v"(Bt[n]), "v"(At[m]), "v"(one8));   \
        else { _Pragma("unroll") for (int k = 0; k < 2; ++k) acc[ai][bj][m][n] = __builtin_amdgcn_mfma_f32_16x16x32_bf16(Bt[n][k], At[m][k], acc[ai][bj][m][n], 0, 0, 0); } } __builtin_amdgcn_s_setprio(0); } while (0)
#define PG8_WAIT_V(n) asm volatile("s_waitcnt vmcnt(" #n ")" ::: "memory")
#define PG8_WAIT_L(n) asm volatile("s_waitcnt lgkmcnt(" #n ")" ::: "memory")
#define PG8_WVS_(NSTR, f_) asm volatile("s_cmp_lg_u32 %0, 0\n\ts_cbranch_scc1 1f\n\ts_waitcnt vmcnt(8)\n\ts_branch 2f\n1:\n\ts_waitcnt vmcnt(" NSTR ")\n2:" : : "s"(f_) : "scc", "memory")
#define PG8_WAIT_VS(flag) do { constexpr int n_ = 8 + Epi::NSTORE + (GATHER ? 4 : 0); const int f_ = __builtin_amdgcn_readfirstlane(flag); static_assert(n_ == 12 || n_ == 16 || n_ == 20 || n_ == 24 || n_ == 28, "relaxed wait count"); \
        if constexpr (n_ == 12) PG8_WVS_("12", f_); else if constexpr (n_ == 16) PG8_WVS_("16", f_); else if constexpr (n_ == 20) PG8_WVS_("20", f_); else if constexpr (n_ == 24) PG8_WVS_("24", f_); else PG8_WVS_("28", f_); } while (0)
#define PG8_BAR __builtin_amdgcn_s_barrier()
#define PG8_SCHED __builtin_amdgcn_sched_barrier(0)
    Unit cur, nxt; int ui = 0;
    if (!S.next(0, cur)) return;
    f32x4 acc[2][2][4][2];
#pragma unroll
    for (int a = 0; a < 2; ++a)
#pragma unroll
        for (int b = 0; b < 2; ++b)
#pragma unroll
            for (int m = 0; m < 4; ++m)
#pragma unroll
                for (int n = 0; n < 2; ++n) acc[a][b][m][n] = (f32x4){0.f, 0.f, 0.f, 0.f};
    typename FragT<FP8>::A At; typename FragT<FP8>::B B0, B1; int one8 = 0x7f7f7f7f; if constexpr (FP8) asm volatile("" : "+v"(one8)); (void)one8;
    const char* cA = (const char*)g.A + (size_t)cur.pm * tstep; const char* cB = (const char*)g.Bt + (size_t)cur.pn * tstep;
    S.a_ready(cur);
    PG8_GOFF(gvc, cur);
    if constexpr (SP2) {
        const char* nA = cA;
        PG8_STAGE(PG8_SB(0, 0), cB, voffB); PG8_STAGE(PG8_SB(0, 1), cB + hstep, voffB); PG8_STAGE_A(PG8_SA(0, 0), false, 0, 0); PG8_STAGE_A(PG8_SA(0, 1), false, 1, 0);
        if (wr == 1) PG8_BAR;
        PG8_WAIT_V(2); PG8_BAR;
        PG8_STAGE(PG8_SB(1, 0), cB + kstep, voffB); PG8_STAGE_A(PG8_SA(1, 0), false, 0, kstep); PG8_STAGE(PG8_SB(1, 1), cB + hstep + kstep, voffB);
        PG8_WAIT_V(6); PG8_BAR;
    } else {
        PG8_STAGE(PG8_SB(0, 0), cB, voffB); PG8_STAGE(PG8_SA(0, 0), cA, voffA); PG8_STAGE(PG8_SB(0, 1), cB + hstep, voffB); PG8_STAGE(PG8_SA(0, 1), cA + hstep, voffA);
        if (wr == 1) PG8_BAR;
        PG8_WAIT_V(4); PG8_BAR;
        PG8_STAGE(PG8_SB(1, 0), cB + kstep, voffB); PG8_STAGE(PG8_SA(1, 0), cA + kstep, voffA); PG8_STAGE(PG8_SB(1, 1), cB + hstep + kstep, voffB);
        PG8_WAIT_V(6); PG8_BAR;
    }
    for (;;) {
        const bool has_next = S.next(ui + 1, nxt);
        const char* nA = has_next ? (const char*)g.A + (size_t)nxt.pm * tstep : cA; const char* nB = has_next ? (const char*)g.Bt + (size_t)nxt.pn * tstep : cB;
        { const Unit& gu_ = has_next ? nxt : cur; PG8_GOFF(gvn, gu_); }
#define PG8_TRIP(W1, W2) do { \
            const bool last = (t == nt - 2); \
            const char* b2 = last ? nB : cB + (size_t)(t + 2) * kstep; const char* b3 = b2 + kstep; \
            if (last && has_next) S.a_ready(nxt); \
            const size_t k1b = (size_t)(t + 1) * kstep, k2b = last ? (size_t)0 : (size_t)(t + 2) * kstep, k3b = k2b + kstep; \
            PG8_LDB(B0, 0, 0); PG8_LDB(B1, 0, 1); PG8_SCHED; PG8_LDA(At, 0, 0); PG8_STAGE_A(PG8_SA(1, 1), false, 1, k1b); \
            W1; PG8_WAIT_L(0); PG8_BAR; PG8_MMA(0, 0, At, B0); PG8_MMA(0, 1, At, B1); PG8_BAR; PG8_SCHED; \
            PG8_LDA(At, 0, 1); PG8_STAGE(PG8_SB(0, 0), b2, voffB); PG8_STAGE(PG8_SB(0, 1), b2 + hstep, voffB); PG8_STAGE_A(PG8_SA(0, 0), last, 0, k2b); \
            W2; PG8_WAIT_L(0); PG8_BAR; PG8_MMA(1, 0, At, B0); PG8_MMA(1, 1, At, B1); PG8_BAR; PG8_SCHED; \
            PG8_LDB(B0, 1, 0); PG8_LDB(B1, 1, 1); PG8_SCHED; PG8_LDA(At, 1, 0); PG8_STAGE_A(PG8_SA(0, 1), last, 1, k2b); \
            PG8_WAIT_V(8); PG8_WAIT_L(0); PG8_BAR; PG8_MMA(0, 0, At, B0); PG8_MMA(0, 1, At, B1); PG8_BAR; PG8_SCHED; \
            PG8_LDA(At, 1, 1); PG8_STAGE(PG8_SB(1, 0), b3, voffB); PG8_STAGE(PG8_SB(1, 1), b3 + hstep, voffB); PG8_STAGE_A(PG8_SA(1, 0), last, 0, k3b); \
            PG8_WAIT_V(8); PG8_WAIT_L(0); PG8_BAR; PG8_MMA(1, 0, At, B0); PG8_MMA(1, 1, At, B1); PG8_BAR; PG8_SCHED; } while (0)
        static_assert(SP2, "only the two-super-phase loop is kept");
        for (int t = 0; t < nt; t += 2) {
            if constexpr (Epi::NSTORE > 0) { const int rlx = (ui > 0 && t == 0) ? 1 : 0;
                PG8_TRIP(PG8_WAIT_VS(rlx), PG8_WAIT_VS(rlx)); }
            else PG8_TRIP(PG8_WAIT_V(8), PG8_WAIT_V(8));
        }
#undef PG8_TRIP
        if constexpr (ALIGN_EPI) { if (wr == 0) PG8_BAR; }
        E(acc, cur, wr, wc); S.done(cur);
        if (!has_next) break;
#pragma unroll
        for (int a = 0; a < 2; ++a)
#pragma unroll
            for (int b = 0; b < 2; ++b)
#pragma unroll
                for (int m = 0; m < 4; ++m)
#pragma unroll
                    for (int n = 0; n < 2; ++n) acc[a][b][m][n] = (f32x4){0.f, 0.f, 0.f, 0.f};
        cur = nxt; cA = nA; cB = nB; ++ui;
        if constexpr (GATHER) { _Pragma("unroll") for (int h_ = 0; h_ < 2; ++h_) _Pragma("unroll") for (int i_ = 0; i_ < 2; ++i_) gvc[h_][i_] = gvn[h_][i_]; }
        if constexpr (ALIGN_EPI) { if (wr == 1) PG8_BAR; }
    }
    PG8_WAIT_V(0);
    if constexpr (!ALIGN_EPI) { if (wr == 0) PG8_BAR; }
    PG8_BAR;
#undef PG8_GOFF
#undef PG8_STAGE_A
#undef PG8_SA
#undef PG8_SB
#undef PG8_STAGE
#undef PG8_LDA
#undef PG8_LDB
#undef PG8_MMA
#undef PG8_WAIT_V
#undef PG8_WAIT_L
#undef PG8_WAIT_VS
#undef PG8_WVS_
#undef PG8_BAR
#undef PG8_SCHED
}
}

constexpr int BATCH = 2, SEQ = 8192, D = 1024, DEPTH = 4, M = BATCH * SEQ;
constexpr int DIN = 4128, NPROJ = 4608, FFD = 2816, FFE = 3584, NEXP = 8, PLE = 256;
constexpr float EPS = 1e-6f, HEAD_EPS = 1e-5f, F_MIN = 1e-6f;
#ifndef F8_DENSE
#define F8_DENSE 0
#endif
#ifndef F8_DDN
#define F8_DDN 0
#endif
#ifndef F8_EGU
#define F8_EGU 1
#endif
constexpr float F8_WMUL = 32.0f, F8_AMUL = 4.0f, F8_GMUL = 16.0f;
constexpr int PC_GQ = 0, PC_GK = 256, PC_GV = 512, PC_GR = 1024, PC_HQ = 1536, PC_HFF = 2048, PC_HFB = 2560, PC_HV = 3072, PC_HR = 3584, PC_GGF = 4096, PC_GGB = 4352;
constexpr int XG_ROWS = 34816;

constexpr size_t MiB = 1u << 20;
constexpr size_t WS_CTL = 0, CTL_ZERO_BYTES = 1 * MiB;
constexpr size_t WS_TAB = 2 * MiB;
constexpr size_t TAB_LB = 0, TAB_LTOK = 64 * 1024, TAB_LW = TAB_LTOK + 512 * 1024, TAB_RSTD = TAB_LW + 512 * 1024, TAB_RINFO = TAB_RSTD + 64 * 1024, TAB_RRSTD = TAB_RINFO + 512 * 1024, TAB_ROWTOK = TAB_RRSTD + 256 * 1024;
constexpr size_t WS_WIN = 8 * MiB;
constexpr size_t WS_WOUT = WS_WIN + 36 * MiB;
constexpr size_t WS_WGU = WS_WOUT + 8 * MiB;
constexpr size_t WS_WDN = WS_WGU + 22 * MiB;
constexpr size_t WS_WEGU = WS_WDN + 11 * MiB;
constexpr size_t WS_WEDN = WS_WEGU + 224 * MiB;
constexpr size_t WS_WPG = WS_WEDN + 112 * MiB;
constexpr size_t WS_WPP = WS_WPG + 8 * MiB;
constexpr size_t WS_HB = WS_WPP + 2 * MiB;
constexpr size_t WS_PB = WS_HB + 32 * MiB;
constexpr size_t WS_Y = WS_PB + 32 * MiB;
constexpr size_t WS_PP = WS_Y + 32 * MiB;
constexpr size_t WS_YS = WS_PP + 32 * MiB;
constexpr size_t WS_XG = WS_YS + 64 * MiB;
constexpr size_t WS_HQ = WS_XG;
constexpr size_t WS_BIG = WS_XG + 68 * MiB;
constexpr size_t WS_HBX = WS_BIG + 238 * MiB;
constexpr size_t WS_END = WS_HBX + 32 * MiB;
constexpr int CW_TMO = 0, CW_BAR = 4096, CW_CNT = 8192, CW_SS = 16384;
static_assert((CW_SS + 13 * M) * 4 <= (int)CTL_ZERO_BYTES, "ctl");

constexpr int NWAVES = 8;
constexpr int RING_OFF = 0, RING_BYTES = 131072;
constexpr int LDSCTL_OFF = RING_BYTES, MISC_OFF = LDSCTL_OFF + 320;
constexpr int LDS_BYTES = 147456;
constexpr int RSTAB_OFF = MISC_OFF + 128, RSTAB_UNITS = 15;
static_assert(RSTAB_OFF % 16 == 0 && RSTAB_OFF + RSTAB_UNITS * 1024 <= LDS_BYTES, "rs table");

#define GAS __attribute__((address_space(1)))
#define LAS __attribute__((address_space(3)))
typedef unsigned short bf16;
typedef unsigned v4u __attribute__((ext_vector_type(4)));
typedef unsigned v2u __attribute__((ext_vector_type(2)));
typedef float f32x4 __attribute__((ext_vector_type(4)));
typedef GAS unsigned gu32;
#define RLX_AGENT __ATOMIC_RELAXED, __HIP_MEMORY_SCOPE_AGENT
#define LDS_WAIT() asm volatile("s_waitcnt lgkmcnt(0)" ::: "memory")
#define VM_WAIT() asm volatile("s_waitcnt vmcnt(0)" ::: "memory")
__device__ __forceinline__ unsigned f2bf(float f) { unsigned u = __builtin_bit_cast(unsigned, f); return (u + 0x7fffu + ((u >> 16) & 1u)) >> 16; }
__device__ __forceinline__ unsigned pk2(float lo, float hi) { return f2bf(lo) | (f2bf(hi) << 16); }
__device__ __forceinline__ float bflo(unsigned w) { return __builtin_bit_cast(float, w << 16); }
__device__ __forceinline__ float bfhi(unsigned w) { return __builtin_bit_cast(float, w & 0xffff0000u); }
__device__ __forceinline__ float bf1(bf16 b) { return __builtin_bit_cast(float, ((unsigned)b) << 16); }
__device__ __forceinline__ float sigm(float x) { return __builtin_amdgcn_rcpf(1.0f + __expf(-x)); }
__device__ __forceinline__ float silu(float x) { return x * __builtin_amdgcn_rcpf(1.0f + __expf(-x)); }
__device__ __forceinline__ float logsig2(float x) { return fminf(x, 0.f) * 1.4426950408889634f - __builtin_amdgcn_logf(1.0f + __builtin_amdgcn_exp2f(-fabsf(x) * 1.4426950408889634f)); }

#define XB_TMO      128
#define XB_XCNT(j)  (256  + 64 * (j))
#define XB_XSUB(j)  (1280 + 64 * (j))
#define XB_XGEN(j)  (2304 + 64 * (j))
#define XB_TOP      3328
#define XB_TOPGEN   3392
#define XCD_BAR_WORDS 3456
#define XB_SPIN_CAP (1u << 18)
__device__ __forceinline__ unsigned xb_ld(unsigned* p)              { return __hip_atomic_load(p, __ATOMIC_RELAXED, __HIP_MEMORY_SCOPE_AGENT); }
__device__ __forceinline__ unsigned xb_add(unsigned* p, unsigned v) { return __hip_atomic_fetch_add(p, v, __ATOMIC_RELAXED, __HIP_MEMORY_SCOPE_AGENT); }
__device__ __forceinline__ unsigned xb_xcc_id() { return (unsigned)__builtin_amdgcn_s_getreg((3 << 11) | 20) & 0xFu; }
#define XB_SPIN(cond, bar) do { unsigned _sp = 0; while (cond) { __builtin_amdgcn_s_sleep(1); \
    if ((++_sp & 255u) == 0u) { if (xb_ld(&(bar)[XB_TMO])) break; if (_sp > XB_SPIN_CAP) { atomicAdd(&(bar)[XB_TMO], 1u); break; } } } } while (0)
struct XcdBarrier { unsigned* bar; unsigned x; volatile LAS unsigned* st; };
__device__ __forceinline__ XcdBarrier xcd_barrier_post(unsigned* bar, volatile LAS unsigned* st) {
    XcdBarrier b; b.bar = bar; b.x = xb_xcc_id(); b.st = st;
    if (threadIdx.x == 0) (void)xb_add(&bar[XB_XCNT(b.x)], 1u);
    return b;
}
__device__ __forceinline__ void xcd_barrier_complete(unsigned* bar, unsigned x, unsigned& nloc, unsigned& nx) {
    const unsigned G = gridDim.x * gridDim.y * gridDim.z;
    unsigned sum, cnt, mine, sp = 0u;
    for (;;) {
        sum = 0u; cnt = 0u; mine = 0u;
#pragma unroll
        for (unsigned j = 0; j < 16; ++j) { const unsigned c = xb_ld(&bar[XB_XCNT(j)]); sum += c; cnt += (c > 0u) ? 1u : 0u; mine = (j == x) ? c : mine; }
        if (sum == G) break;
        __builtin_amdgcn_s_sleep(1);
        if ((++sp & 255u) == 0u) { if (xb_ld(&bar[XB_TMO])) break; if (sp > XB_SPIN_CAP) { atomicAdd(&bar[XB_TMO], 1u); break; } }
    }
    nloc = mine > 0u ? mine : 1u; nx = cnt > 0u ? cnt : 1u;
}
__device__ __forceinline__ void xcd_barrier(const XcdBarrier& b) {
    asm volatile("s_waitcnt vmcnt(0)" ::: "memory");
    __syncthreads();
    if (threadIdx.x == 0) {
        unsigned* bar = b.bar;
        __builtin_amdgcn_s_waitcnt(0);
        unsigned nloc = b.st[0], nx = b.st[1];
        if (nloc == 0u) { xcd_barrier_complete(bar, b.x, nloc, nx); b.st[0] = nloc; b.st[1] = nx; }
        const unsigned old = xb_add(&bar[XB_XSUB(b.x)], 1u);
        const unsigned gen = old / nloc;
        if (old + 1u == (gen + 1u) * nloc) {
            __builtin_amdgcn_fence(__ATOMIC_RELEASE, "agent");
            asm volatile("s_waitcnt vmcnt(0)" ::: "memory");
            const unsigned og = xb_add(&bar[XB_TOP], 1u);
            const unsigned tg = og / nx;
            if (og + 1u == (tg + 1u) * nx) xb_add(&bar[XB_TOPGEN], 1u);
            else XB_SPIN(xb_ld(&bar[XB_TOPGEN]) == tg, bar);
            __builtin_amdgcn_fence(__ATOMIC_ACQUIRE, "agent");
            xb_add(&bar[XB_XGEN(b.x)], 1u);
            asm volatile("s_waitcnt vmcnt(0)" ::: "memory");
        } else {
            XB_SPIN(xb_ld(&bar[XB_XGEN(b.x)]) == gen, bar);
            __builtin_amdgcn_fence(__ATOMIC_ACQUIRE, "agent");
            asm volatile("s_waitcnt vmcnt(0)" ::: "memory");
        }
    }
    __syncthreads();
}

__device__ __forceinline__ int lane_id() { int l; asm volatile("v_mbcnt_lo_u32_b32 %0, -1, 0\n\tv_mbcnt_hi_u32_b32 %0, -1, %0" : "=v"(l)); return l; }
__device__ __forceinline__ int opq_s(int x) { asm volatile("" : "+s"(x)); return x; }
__device__ __forceinline__ int opq_v(int x) { asm volatile("" : "+v"(x)); return x; }
constexpr size_t WS_SSP = WS_TAB + 3 * MiB;
__device__ __forceinline__ float ss_load(const float* part, int row) {
    const f32x4* p = (const f32x4*)(part + (size_t)row * 16); const f32x4 a = p[0], b = p[1], c = p[2], d = p[3];
    return (((a[0] + a[1]) + (a[2] + a[3])) + ((b[0] + b[1]) + (b[2] + b[3]))) + (((c[0] + c[1]) + (c[2] + c[3])) + ((d[0] + d[1]) + (d[2] + d[3])));
}
using pg8::Unit; using pg8::bf16_t; using pg8::u32x4; using pg8::u32x2; using pg8::cvt_pk_bf16;
struct EpiProj {
    static constexpr bool PERM = true; static constexpr int NSTORE = 16;
    bf16_t* P; const LAS float* rstab; const float* lb; const float* bg;
    template <int MODE> __device__ __forceinline__ void run(const f32x4 (&acc)[2][2][4][2], const Unit& u, int wr, int wc, float scale, const float* aux) const {
        const int lane_e = lane_id(), fr = lane_e & 15, fq = lane_e >> 4;
        const int pn = u.pn, row0 = u.pm * 256 + wr * 64 + fr, cw = wc * 64 + 8 * fq;
        f32x4 ax[2][2];
#pragma unroll
        for (int bj = 0; bj < 2; ++bj)
#pragma unroll
            for (int n = 0; n < 2; ++n) ax[bj][n] = (MODE >= 2) ? *(const f32x4*)(aux + bj * 32 + cw + 4 * n) : (f32x4){0.f, 0.f, 0.f, 0.f};
        float rs8[2][4];
#pragma unroll
        for (int ai = 0; ai < 2; ++ai)
#pragma unroll
            for (int m = 0; m < 4; ++m) rs8[ai][m] = rstab[u.ord * 256 + wr * 64 + fr + ai * 128 + m * 16];
        if (MODE >= 2) asm volatile("s_waitcnt vmcnt(0)" ::: "memory");
#pragma unroll
        for (int ai = 0; ai < 2; ++ai)
#pragma unroll
            for (int m = 0; m < 4; ++m) {
                const int row = row0 + ai * 128 + m * 16;
                const float rs = rs8[ai][m];
                bf16_t* rowp = P + (size_t)row * NPROJ + pn * 256 + cw;
#pragma unroll
                for (int bj = 0; bj < 2; ++bj) {
                    float v[8];
#pragma unroll
                    for (int n = 0; n < 2; ++n) {
                        const f32x4 T = acc[ai][bj][m][n] * (MODE == 0 ? rs * scale : MODE == 3 ? rs : rs * 1.4426950408889634f); f32x4 ov;
                        if (MODE == 0) ov = T;
                        else if (MODE == 3) {
#pragma unroll
                            for (int j = 0; j < 4; ++j) ov[j] = logsig2(T[j] + ax[bj][n][j]) * 0.0625f;
                        } else { f32x4 sg;
#pragma unroll
                            for (int j = 0; j < 4; ++j) sg[j] = __builtin_amdgcn_rcpf(1.0f + __builtin_amdgcn_exp2f(-T[j]));
                            if (MODE == 1) ov = (T * sg) * (scale * 0.6931471805599453f);
                            else { const f32x4 f = ax[bj][n] + (1.0f - ax[bj][n]) * sg;
#pragma unroll
                                for (int j = 0; j < 4; ++j) ov[j] = __builtin_amdgcn_logf(fmaxf(f[j], F_MIN)); }
                        }
#pragma unroll
                        for (int j = 0; j < 4; ++j) v[n * 4 + j] = ov[j];
                    }
                    u32x4 w; w.x = cvt_pk_bf16(v[0], v[1]); w.y = cvt_pk_bf16(v[2], v[3]); w.z = cvt_pk_bf16(v[4], v[5]); w.w = cvt_pk_bf16(v[6], v[7]);
                    *(u32x4*)(rowp + bj * 32) = w;
                }
            }
    }
    __device__ __forceinline__ void operator()(const f32x4 (&acc)[2][2][4][2], const Unit& u, int wr, int wc) const {
        const int pn = u.pn;
        if (pn == 0) run<0>(acc, u, wr, wc, 0.125f, nullptr);
        else if (pn == 4 || pn == 5 || pn == 14 || pn == 15) run<1>(acc, u, wr, wc, 1.f, nullptr);
        else if (pn == 6 || pn == 7) run<1>(acc, u, wr, wc, 0.08838834764831845f, nullptr);
        else if (pn >= 8 && pn <= 11) run<2>(acc, u, wr, wc, 1.f, lb + ((pn - 8) >> 1) * 512 + ((pn - 8) & 1) * 256);
        else if (pn >= 16) run<3>(acc, u, wr, wc, 1.f, bg + (pn - 16) * 256);
        else run<0>(acc, u, wr, wc, 1.f, nullptr);
    }
};
template <int KIND> struct EpiRes {
    static constexpr bool PERM = true; static constexpr int NSTORE = 0;
    const bf16_t* hin; bf16_t* hout; float* ss_out; const float* ss_in; const bf16_t* pp; unsigned char* hq; float ascale;
    __device__ __forceinline__ void operator()(const f32x4 (&acc)[2][2][4][2], const Unit& u, int wr, int wc) const {
        const int lane_e = lane_id(), fr = lane_e & 15, fq = lane_e >> 4;
        const int row0 = u.pm * 256 + wr * 64 + fr, col0 = u.pn * 256 + wc * 32 + 8 * fq;
#pragma unroll
        for (int ai = 0; ai < 2; ++ai)
#pragma unroll
        for (int mh = 0; mh < 2; ++mh) {
            u32x4 hw[4][2], pw[4][2]; float rs4[4];
#pragma unroll
            for (int m = 2 * mh; m < 2 * mh + 2; ++m) { const int row = row0 + ai * 128 + m * 16; rs4[m] = 0.f;
                if (KIND == 1) rs4[m] = ss_load(ss_in, row);
#pragma unroll
                for (int bj = 0; bj < 2; ++bj) { const size_t off = (size_t)row * D + col0 + bj * 128; hw[m][bj] = *(const u32x4*)(hin + off); if (KIND == 1) pw[m][bj] = *(const u32x4*)(pp + off); } }
#pragma unroll
            for (int m = 2 * mh; m < 2 * mh + 2; ++m) {
                const int row = row0 + ai * 128 + m * 16; float sq = 0.f; const float rs = (KIND == 1) ? rsqrtf(rs4[m] * (1.0f / 1024.0f) + EPS) : 0.f;
#pragma unroll
                for (int bj = 0; bj < 2; ++bj) {
                    const size_t off = (size_t)row * D + col0 + bj * 128;
                    const u32x4 h_ = hw[m][bj]; const f32x4 a0 = acc[ai][bj][m][0], a1 = acc[ai][bj][m][1];
                    f32x4 h0 = (f32x4){bflo(h_.x), bfhi(h_.x), bflo(h_.y), bfhi(h_.y)}, h1 = (f32x4){bflo(h_.z), bfhi(h_.z), bflo(h_.w), bfhi(h_.w)};
                    if (KIND == 1) { const u32x4 p_ = pw[m][bj];
                        h0[0] += bflo(p_.x) * sigm(a0[0] * rs); h0[1] += bfhi(p_.x) * sigm(a0[1] * rs); h0[2] += bflo(p_.y) * sigm(a0[2] * rs); h0[3] += bfhi(p_.y) * sigm(a0[3] * rs);
                        h1[0] += bflo(p_.z) * sigm(a1[0] * rs); h1[1] += bfhi(p_.z) * sigm(a1[1] * rs); h1[2] += bflo(p_.w) * sigm(a1[2] * rs); h1[3] += bfhi(p_.w) * sigm(a1[3] * rs);
                    } else { h0 += a0 * ascale; h1 += a1 * ascale; }
                    u32x4 w; w.x = cvt_pk_bf16(h0[0], h0[1]); w.y = cvt_pk_bf16(h0[2], h0[3]); w.z = cvt_pk_bf16(h1[0], h1[1]); w.w = cvt_pk_bf16(h1[2], h1[3]); *(u32x4*)(hout + off) = w;
                    if (KIND == 0 && hq) { int q0 = 0, q1 = 0; q0 = __builtin_amdgcn_cvt_pk_fp8_f32(h0[0], h0[1], q0, false); q0 = __builtin_amdgcn_cvt_pk_fp8_f32(h0[2], h0[3], q0, true);
                        q1 = __builtin_amdgcn_cvt_pk_fp8_f32(h1[0], h1[1], q1, false); q1 = __builtin_amdgcn_cvt_pk_fp8_f32(h1[2], h1[3], q1, true); *(u32x2*)(hq + off) = (u32x2){(unsigned)q0, (unsigned)q1}; }
                    const float r0 = bflo(w.x), r1 = bfhi(w.x), r2 = bflo(w.y), r3 = bfhi(w.y), r4 = bflo(w.z), r5 = bfhi(w.z), r6 = bflo(w.w), r7 = bfhi(w.w);
                    sq += ((r0 * r0 + r1 * r1) + (r2 * r2 + r3 * r3)) + ((r4 * r4 + r5 * r5) + (r6 * r6 + r7 * r7));
                }
                sq += __builtin_bit_cast(float, __builtin_amdgcn_ds_bpermute((lane_e ^ 16) << 2, __builtin_bit_cast(int, sq))); sq += __builtin_bit_cast(float, __builtin_amdgcn_ds_bpermute((lane_e ^ 32) << 2, __builtin_bit_cast(int, sq)));
                if (fq == 0) ss_out[(size_t)row * 16 + u.pn * 4 + wc] = sq;
            }
            asm volatile("" ::: "memory");
        }
    }
};
template <bool F8OUT> struct EpiSwiGLU {
    static constexpr bool PERM = true; static constexpr int NSTORE = 8;
    bf16_t* O; int ldo; const LAS float* rstab;
    __device__ __forceinline__ void operator()(const f32x4 (&acc)[2][2][4][2], const Unit& u, int wr, int wc) const {
        const int lane_e = lane_id(), fr = lane_e & 15, fq = lane_e >> 4;
        const int row0 = u.pm * 256 + wr * 64 + fr, oc = u.pnl * 128 + wc * 32 + 8 * fq;
        float rs8[2][4];
#pragma unroll
        for (int ai = 0; ai < 2; ++ai)
#pragma unroll
            for (int m = 0; m < 4; ++m) rs8[ai][m] = rstab[u.ord * 256 + wr * 64 + fr + ai * 128 + m * 16];
#pragma unroll
        for (int ai = 0; ai < 2; ++ai)
#pragma unroll
            for (int m = 0; m < 4; ++m) {
                const int row = row0 + ai * 128 + m * 16;
                const float rs = rs8[ai][m];
                const float sg = rs * 1.4426950408889634f, su = rs * ((F8OUT ? (float)F8_AMUL : 1.0f) * 0.6931471805599453f);
                float v[8];
#pragma unroll
                for (int n = 0; n < 2; ++n) {
                    const f32x4 Gv = acc[ai][0][m][n] * sg, Uv = acc[ai][1][m][n] * su; f32x4 dn;
#pragma unroll
                    for (int j = 0; j < 4; ++j) dn[j] = __builtin_amdgcn_rcpf(1.0f + __builtin_amdgcn_exp2f(-Gv[j]));
                    const f32x4 ov = (Gv * Uv) * dn;
#pragma unroll
                    for (int j = 0; j < 4; ++j) v[n * 4 + j] = ov[j];
                }
                if (F8OUT) { int w0 = 0, w1 = 0;
                    w0 = __builtin_amdgcn_cvt_pk_fp8_f32(v[0], v[1], w0, false); w0 = __builtin_amdgcn_cvt_pk_fp8_f32(v[2], v[3], w0, true);
                    w1 = __builtin_amdgcn_cvt_pk_fp8_f32(v[4], v[5], w1, false); w1 = __builtin_amdgcn_cvt_pk_fp8_f32(v[6], v[7], w1, true);
                    *(u32x2*)((unsigned char*)O + (size_t)row * ldo + oc) = (u32x2){(unsigned)w0, (unsigned)w1}; }
                else { u32x4 w; w.x = cvt_pk_bf16(v[0], v[1]); w.y = cvt_pk_bf16(v[2], v[3]); w.z = cvt_pk_bf16(v[4], v[5]); w.w = cvt_pk_bf16(v[6], v[7]);
                    *(u32x4*)(O + (size_t)row * ldo + oc) = w; }
            }
    }
};
struct EpiScatter {
    static constexpr bool PERM = true; static constexpr int NSTORE = 0;
    bf16_t* YS; const int* ltok; const float* lw;
    __device__ __forceinline__ void operator()(const f32x4 (&acc)[2][2][4][2], const Unit& u, int wr, int wc) const {
        const int lane_e = lane_id(), fr = lane_e & 15, fq = lane_e >> 4;
        const int oc = u.pnl * 256 + wc * 32 + 8 * fq;
        int rx8[2][4]; float wg8[2][4];
#pragma unroll
        for (int ai = 0; ai < 2; ++ai)
#pragma unroll
            for (int m = 0; m < 4; ++m) { const int rl = wr * 64 + fr + ai * 128 + m * 16, ri = u.rbase + (rl < u.nvalid ? rl : u.nvalid - 1); rx8[ai][m] = ltok[ri]; wg8[ai][m] = lw[ri]; }
#pragma unroll
        for (int ai = 0; ai < 2; ++ai)
#pragma unroll
            for (int m = 0; m < 4; ++m) {
                const int rl = wr * 64 + fr + ai * 128 + m * 16;
                if (rl < u.nvalid) {
                    const int rx = rx8[ai][m]; const int tok = rx & 0xffff, rank = (rx >> 16) & 1; const float wgt = wg8[ai][m] * (1.0f / (F8_WMUL * F8_AMUL));
                    bf16_t* rowp = YS + ((size_t)rank * M + tok) * D + oc;
#pragma unroll
                    for (int bj = 0; bj < 2; ++bj) { const f32x4 a0 = acc[ai][bj][m][0] * wgt, a1 = acc[ai][bj][m][1] * wgt;
                        u32x4 w; w.x = cvt_pk_bf16(a0[0], a0[1]); w.y = cvt_pk_bf16(a0[2], a0[3]); w.z = cvt_pk_bf16(a1[0], a1[1]); w.w = cvt_pk_bf16(a1[2], a1[3]);
                        *(u32x4*)(rowp + bj * 128) = w; }
                }
            }
    }
};
struct EpiBf16Plain {
    static constexpr bool PERM = false; static constexpr int NSTORE = 0;
    bf16_t* O;
    __device__ __forceinline__ void operator()(const f32x4 (&acc)[2][2][4][2], const Unit& u, int wr, int wc) const {
        const int lane_e = lane_id(), fr = lane_e & 15, fq = lane_e >> 4;
        const int row0 = u.pm * 256 + wr * 64 + fr, col0 = u.pn * 256 + wc * 32 + 4 * fq;
#pragma unroll
        for (int ai = 0; ai < 2; ++ai)
#pragma unroll
            for (int m = 0; m < 4; ++m)
#pragma unroll
                for (int bj = 0; bj < 2; ++bj)
#pragma unroll
                    for (int n = 0; n < 2; ++n) { const f32x4 a = acc[ai][bj][m][n]; u32x2 w; w.x = cvt_pk_bf16(a[0], a[1]); w.y = cvt_pk_bf16(a[2], a[3]);
                        *(u32x2*)(O + (size_t)(row0 + ai * 128 + m * 16) * D + col0 + bj * 128 + n * 16) = w; }
    }
};


template <class Sched> __device__ __forceinline__ void fill_rs_table(LAS float* tab, const Sched& S, const float* ssp, const float* rdir, float scale, int tid, const int* ltok = nullptr) {
    pg8::Unit u;
    for (int i = 0; i < RSTAB_UNITS && S.next(i, u); i += 2) {
        pg8::Unit u2; const bool two = S.next(i + 1, u2) && (i + 1 < RSTAB_UNITS);
        const int sel = tid >> 8, rl = tid & 255;
        if (sel == 0 || two) { const int row = (sel ? u2.pm : u.pm) * 256 + rl;
            const pg8::Unit& uu = sel ? u2 : u;
            tab[(i + sel) * 256 + rl] = (rdir ? rdir[ltok[uu.rbase + (rl < uu.nvalid ? rl : uu.nvalid - 1)] & 0xffff] : rsqrtf(ss_load(ssp, row) * (1.0f / 1024.0f) + EPS)) * scale; }
    }
    __syncthreads();
}
struct Args { const float* in[22]; float* out; unsigned char* ws; int ph_lo, ph_hi, flags, pad_; };
enum { I_X = 0, I_P, I_WIN, I_WG2, I_BG, I_LBL, I_GON, I_HON, I_WOUT, I_NMIX, I_NFFN, I_WDG, I_WDU, I_WDD, I_WR, I_WEG, I_WEU, I_WED, I_WPP, I_WPG, I_NPLE, I_NFIN };

__device__ __forceinline__ float wave_sum(float v, int lane) {
#pragma unroll
    for (int o = 1; o < 64; o <<= 1) v += __builtin_bit_cast(float, __builtin_amdgcn_ds_bpermute((lane ^ o) << 2, __builtin_bit_cast(int, v)));
    return v;
}

__device__ __forceinline__ void tr_writeout(bf16* WT, int K, int drow, int k0, LAS float* scr, int lane) {
    LDS_WAIT(); asm volatile("" ::: "memory");
    const int c = lane & 7;
#pragma unroll
    for (int j = 0; j < 4; ++j) { const int n = (lane >> 3) + 8 * j; const LAS float* s = scr + (8 * c) * 33 + n;
        v4u o; o.x = pk2(s[0 * 33], s[1 * 33]); o.y = pk2(s[2 * 33], s[3 * 33]); o.z = pk2(s[4 * 33], s[5 * 33]); o.w = pk2(s[6 * 33], s[7 * 33]);
        *(GAS v4u*)(WT + (size_t)(drow + n) * K + k0 + 8 * c) = o; }
    LDS_WAIT(); asm volatile("" ::: "memory");
}
__device__ __forceinline__ void tr_item(const float* W, int ldn, int K, int scol, bf16* WT, int drow, int k0, const float* scale, LAS float* scr, int lane) {
#pragma unroll 8
    for (int i = 0; i < 32; ++i) { const int kk = 2 * i + (lane >> 5); float v = W[(size_t)(k0 + kk) * ldn + scol + (lane & 31)]; if (scale) v *= scale[k0 + kk]; scr[kk * 33 + (lane & 31)] = v; }
    tr_writeout(WT, K, drow, k0, scr, lane);
}

struct Desc { const float* W; int ldn, K, ncols, scol0; bf16* WT; int drow0, ilv; const float* scale; float f8mul; };
constexpr int ND = 74;
typedef const __attribute__((address_space(4))) Args* KArgs;
__device__ __forceinline__ KArgs kargs() { KArgs p = (KArgs)__builtin_amdgcn_kernarg_segment_ptr(); asm volatile("" : "+s"(p)); return p; }
__device__ __forceinline__ Desc get_desc(KArgs ap, int d) {
    Desc r; unsigned char* ws = ap->ws; const float* const* in_ = nullptr; (void)in_;
    if (d < 20) { const int i = d / 5, q = d % 5;
        if (q == 0) r = Desc{ap->in[I_WIN] + (size_t)i * D * DIN, DIN, D, 1536, 0, (bf16*)(ws + WS_WIN) + (size_t)i * NPROJ * D, 0, 3, ap->in[I_NMIX] + i * D};
        else if (q == 1) r = Desc{ap->in[I_WIN] + (size_t)i * D * DIN, DIN, D, 2560, 1568, (bf16*)(ws + WS_WIN) + (size_t)i * NPROJ * D, 1536, 3, ap->in[I_NMIX] + i * D};
        else if (q == 2) r = Desc{ap->in[I_WOUT] + (size_t)i * D * D, D, D, D, 0, (bf16*)(ws + WS_WOUT) + (size_t)i * D * D, 0, 0, nullptr};
        else if (q == 3) r = Desc{ap->in[I_WPG] + (size_t)i * D * D, D, D, D, 0, (bf16*)(ws + WS_WPG) + (size_t)i * D * D, 0, 0, ap->in[I_NPLE] + i * D};
        else r = Desc{ap->in[I_WPP] + (size_t)i * PLE * D, D, PLE, D, 0, (bf16*)(ws + WS_WPP) + (size_t)i * D * PLE, 0, 0, nullptr};
    } else if (d < 26) { const int j = (d - 20) / 3, q = (d - 20) % 3;
#if F8_DENSE
        if (q == 0) r = Desc{ap->in[I_WDG] + (size_t)j * D * FFD, FFD, D, FFD, 0, (bf16*)((unsigned char*)(ws + WS_WGU) + (size_t)j * 2 * FFD * D), 0, 1, ap->in[I_NFFN] + (2 * j) * D, F8_GMUL};
        else if (q == 1) r = Desc{ap->in[I_WDU] + (size_t)j * D * FFD, FFD, D, FFD, 0, (bf16*)((unsigned char*)(ws + WS_WGU) + (size_t)j * 2 * FFD * D), 0, 2, ap->in[I_NFFN] + (2 * j) * D, F8_GMUL};
        else r = Desc{ap->in[I_WDD] + (size_t)j * FFD * D, D, FFD, D, 0, (bf16*)((unsigned char*)(ws + WS_WDN) + (size_t)j * D * FFD), 0, 0, nullptr, F8_WMUL};
#else
        if (q == 0) r = Desc{ap->in[I_WDG] + (size_t)j * D * FFD, FFD, D, FFD, 0, (bf16*)(ws + WS_WGU) + (size_t)j * 2 * FFD * D, 0, 1, ap->in[I_NFFN] + (2 * j) * D};
        else if (q == 1) r = Desc{ap->in[I_WDU] + (size_t)j * D * FFD, FFD, D, FFD, 0, (bf16*)(ws + WS_WGU) + (size_t)j * 2 * FFD * D, 0, 2, ap->in[I_NFFN] + (2 * j) * D};
#if F8_DDN
        else r = Desc{ap->in[I_WDD] + (size_t)j * FFD * D, D, FFD, D, 0, (bf16*)((unsigned char*)(ws + WS_WDN) + (size_t)j * D * FFD), 0, 0, nullptr, F8_WMUL};
#else
        else r = Desc{ap->in[I_WDD] + (size_t)j * FFD * D, D, FFD, D, 0, (bf16*)(ws + WS_WDN) + (size_t)j * D * FFD, 0, 0, nullptr};
#endif
#endif
    } else { const int je = (d - 26) / 3, q = (d - 26) % 3, j = je / 8;
#if F8_EGU
        if (q == 0) r = Desc{ap->in[I_WEG] + (size_t)je * D * FFE, FFE, D, FFE, 0, (bf16*)((unsigned char*)(ws + WS_WEGU) + (size_t)je * 2 * FFE * D), 0, 1, ap->in[I_NFFN] + (2 * j + 1) * D, F8_GMUL};
        else if (q == 1) r = Desc{ap->in[I_WEU] + (size_t)je * D * FFE, FFE, D, FFE, 0, (bf16*)((unsigned char*)(ws + WS_WEGU) + (size_t)je * 2 * FFE * D), 0, 2, ap->in[I_NFFN] + (2 * j + 1) * D, F8_GMUL};
#else
        if (q == 0) r = Desc{ap->in[I_WEG] + (size_t)je * D * FFE, FFE, D, FFE, 0, (bf16*)(ws + WS_WEGU) + (size_t)je * 2 * FFE * D, 0, 1, ap->in[I_NFFN] + (2 * j + 1) * D};
        else if (q == 1) r = Desc{ap->in[I_WEU] + (size_t)je * D * FFE, FFE, D, FFE, 0, (bf16*)(ws + WS_WEGU) + (size_t)je * 2 * FFE * D, 0, 2, ap->in[I_NFFN] + (2 * j + 1) * D};
#endif
        else r = Desc{ap->in[I_WED] + (size_t)je * FFE * D, D, FFE, D, 0, (bf16*)((unsigned char*)(ws + WS_WEDN) + (size_t)je * D * FFE), 0, 0, nullptr, F8_WMUL};
    }
    return r;
}


constexpr int ND_PRO = 50;
__device__ __forceinline__ void convert_descs(KArgs A, int d_lo, int d_hi, int gwv, int ngw, LAS float* scr, int lane) {
    struct ItemRef { const float* src; const float* sc; bf16* dst; int ldn, K; float f8; };
    int d_ = d_lo, it_ = -1, base_ = 0;
#define PRO_NEXT(ok_, ref_) do { ok_ = false; while (d_ < d_hi) { const Desc ds = get_desc(A, d_); const int nnb = ds.ncols / 32, ni = (ds.K / 64) * nnb; \
        if (it_ < 0) { int f_ = (gwv - base_) % ngw; if (f_ < 0) f_ += ngw; it_ = f_; } \
        if (it_ < ni) { const int kb = it_ / nnb, nb = it_ % nnb, c = 32 * nb; const int drow = ds.ilv == 3 ? (ds.drow0 + (c & ~255) + 32 * (4 * ((c >> 5) & 1) + ((c >> 6) & 3))) : ds.ilv ? (ds.drow0 + 256 * (c / 128) + 128 * (ds.ilv - 1) + (c % 128)) : (ds.drow0 + c); \
            ref_.src = ds.W + (size_t)(64 * kb) * ds.ldn + ds.scol0 + c; ref_.sc = ds.scale ? ds.scale + 64 * kb : nullptr; ref_.f8 = ds.f8mul; ref_.dst = ds.f8mul != 0.f ? (bf16*)((unsigned char*)ds.WT + (size_t)drow * ds.K + 64 * kb) : ds.WT + (size_t)drow * ds.K + 64 * kb; ref_.ldn = ds.ldn; ref_.K = ds.K; it_ += ngw; ok_ = true; break; } \
        base_ = (base_ + ni) % ngw; ++d_; it_ = -1; } } while (0)
#define PRO_LOAD(v_, ref_) do { const float* p_ = ref_.src + (size_t)(lane >> 5) * ref_.ldn + (lane & 31); const size_t st_ = (size_t)2 * ref_.ldn; \
        _Pragma("unroll") for (int i = 0; i < 32; ++i) v_[i] = __builtin_nontemporal_load(p_ + i * st_); } while (0)
#define PRO_PROC(v_, ref_) do { \
        _Pragma("unroll") for (int i = 0; i < 32; ++i) scr[(2 * i + (lane >> 5)) * 33 + (lane & 31)] = v_[i]; \
        LDS_WAIT(); asm volatile("" ::: "memory"); \
        const int c_ = lane & 7; f32x4 s0_ = (f32x4){1.f, 1.f, 1.f, 1.f}, s1_ = s0_; if (ref_.sc) { s0_ = *(const f32x4*)(ref_.sc + 8 * c_); s1_ = *(const f32x4*)(ref_.sc + 8 * c_ + 4); } \
        _Pragma("unroll") for (int j = 0; j < 4; ++j) { const int n_ = (lane >> 3) + 8 * j; const LAS float* s_ = scr + (8 * c_) * 33 + n_; \
            if (ref_.f8 != 0.f) { const float m_ = ref_.f8; int w0_ = 0, w1_ = 0; \
                w0_ = __builtin_amdgcn_cvt_pk_fp8_f32(s_[0 * 33] * s0_[0] * m_, s_[1 * 33] * s0_[1] * m_, w0_, false); w0_ = __builtin_amdgcn_cvt_pk_fp8_f32(s_[2 * 33] * s0_[2] * m_, s_[3 * 33] * s0_[3] * m_, w0_, true); \
                w1_ = __builtin_amdgcn_cvt_pk_fp8_f32(s_[4 * 33] * s1_[0] * m_, s_[5 * 33] * s1_[1] * m_, w1_, false); w1_ = __builtin_amdgcn_cvt_pk_fp8_f32(s_[6 * 33] * s1_[2] * m_, s_[7 * 33] * s1_[3] * m_, w1_, true); \
                __builtin_nontemporal_store((v2u){(unsigned)w0_, (unsigned)w1_}, (GAS v2u*)((unsigned char*)ref_.dst + (size_t)n_ * ref_.K + 8 * c_)); } \
            else { v4u o_; o_.x = pk2(s_[0 * 33] * s0_[0], s_[1 * 33] * s0_[1]); o_.y = pk2(s_[2 * 33] * s0_[2], s_[3 * 33] * s0_[3]); o_.z = pk2(s_[4 * 33] * s1_[0], s_[5 * 33] * s1_[1]); o_.w = pk2(s_[6 * 33] * s1_[2], s_[7 * 33] * s1_[3]); \
            __builtin_nontemporal_store(o_, (GAS v4u*)(ref_.dst + (size_t)n_ * ref_.K + 8 * c_)); } } \
        LDS_WAIT(); asm volatile("" ::: "memory"); } while (0)
    ItemRef ra, rb; bool oka, okb; float va[32], vb[32];
    PRO_NEXT(oka, ra); if (oka) PRO_LOAD(va, ra);
    while (oka) {
        PRO_NEXT(okb, rb); if (okb) PRO_LOAD(vb, rb);
        PRO_PROC(va, ra);
        if (!okb) break;
        PRO_NEXT(oka, ra); if (oka) PRO_LOAD(va, ra);
        PRO_PROC(vb, rb);
    }
#undef PRO_NEXT
#undef PRO_LOAD
#undef PRO_PROC
}

namespace scan {
typedef short s16x8 __attribute__((ext_vector_type(8)));
typedef short s16x4 __attribute__((ext_vector_type(4)));
typedef short v4i16_t __attribute__((ext_vector_type(4)));
__device__ __forceinline__ s16x4 vtr(const LAS unsigned char* p) { return __builtin_bit_cast(s16x4, __builtin_amdgcn_ds_read_tr16_b64_v4i16((LAS v4i16_t*)p)); }
__device__ __forceinline__ s16x8 cat(s16x4 a, s16x4 b) { return __builtin_shufflevector(a, b, 0, 1, 2, 3, 4, 5, 6, 7); }
__device__ __forceinline__ f32x4 mma(s16x8 a, s16x8 b, f32x4 c) { return __builtin_amdgcn_mfma_f32_16x16x32_bf16(a, b, c, 0, 0, 0); }
__device__ __forceinline__ s16x8 tri_pat(int g, int c16, int pi) { s16x8 r;
#pragma unroll
    for (int j = 0; j < 8; ++j) r[j] = (8 * g + j <= c16 + 16 * pi) ? (short)0x3F80 : (short)0;
    return r; }
__device__ __forceinline__ v2u pack4(float a, float b, float c, float d) { v2u r; r.x = pg8::cvt_pk_bf16(a, b); r.y = pg8::cvt_pk_bf16(c, d); return r; }
__device__ __forceinline__ f32x4 unpack4(v2u w) { return (f32x4){bflo(w.x), bfhi(w.x), bflo(w.y), bfhi(w.y)}; }

constexpr size_t E_G_OFF = 0, E_H_OFF = 16 * MiB, D_OFF = 48 * MiB;
__device__ __forceinline__ size_t e_index(int unit, int dir, int w, int ndt, int dt, int lane) { return ((((size_t)unit * 2 + dir) * 8 + w) * ndt + dt) * 64 + lane; }
__device__ __forceinline__ size_t d_index(int grp, int seq, int dir, int seg, int dim) { return ((((size_t)grp * 8 + seq) * 2 + dir) * 32 + seg) * 128 + dim; }

#define EX2(x) __builtin_amdgcn_exp2f(x)
__device__ __forceinline__ float dppf(float x, int ctrl_sel) {
    const int xi = __builtin_bit_cast(int, x); int r;
    if (ctrl_sel == 0) r = __builtin_amdgcn_update_dpp(0, xi, 0xB1, 0xF, 0xF, true);
    else if (ctrl_sel == 1) r = __builtin_amdgcn_update_dpp(0, xi, 0x4E, 0xF, 0xF, true);
    else if (ctrl_sel == 2) r = __builtin_amdgcn_update_dpp(0, xi, 0x141, 0xF, 0xF, true);
    else r = __builtin_amdgcn_update_dpp(0, xi, 0x140, 0xF, 0xF, true);
    return __builtin_bit_cast(float, r); }
__device__ __forceinline__ float row16_sum(float x) { x += dppf(x, 0); x += dppf(x, 1); x += dppf(x, 2); x += dppf(x, 3); return x; }
template <int DK, bool HG, bool PB>
__device__ __forceinline__ void scan_unit(const bf16* P, float* OFf, f32x4* Ebuf, float* Dbuf, bf16* Y, const float* onw, int unit, LAS unsigned char* lds, int w, int lane) {
    constexpr int RS = DK * 2 + 16, NDT = DK / 16, NKS = DK / 32, PPR = DK / 8;
    constexpr int QT = 0, GT = 64 * RS, KT = 2 * 64 * RS, VT = 3 * 64 * RS, AT = GT, VEC = VT + 64 * 272, OFL = VEC + 2 * 1536, NOFL = HG ? 3 : 4, OFC = 64 * 272, HN = 129024;
    static_assert(64 * 144 <= 64 * RS && OFL + NOFL * OFC <= HN && HN + 2048 <= 131072, "scan LDS map");
    const int lane0 = lane;
    const int fl = PB ? opq_s(kargs()->flags) : 0;
#define LDT(p_) (((fl & 2) && dir_) ? __builtin_nontemporal_load((const v4u*)(p_)) : *(const v4u*)(p_))
#define SCAN_LANE() const int ln_ = opq_v(lane0), g = ln_ >> 4, c16 = ln_ & 15, q4 = c16 >> 2, p4 = c16 & 3, tid = w * 64 + ln_; (void)g; (void)c16; (void)q4; (void)p4; (void)tid;

    const int seq = unit >> 5, seg = unit & 31, b = seq >> 2, hh = seq & 3;
    const int qc = HG ? PC_HQ + hh * 128 : PC_GQ + hh * 64, kc = PC_GK + hh * 64, vc = (HG ? PC_HV : PC_GV) + hh * 128;
#define SCAN_GATEC ((HG ? PC_HR : PC_GR) + hh * 128 + 16 * w + c16)
#define SCAN_YCOL ((HG ? 512 : 0) + hh * 128 + 16 * w + c16)
    const int tok0 = b * SEQ + seg * 256;
    const int cdt = HG ? w : (w >> 1), ctt0 = HG ? 0 : 2 * (w & 1), cntt = HG ? 4 : 2;
    f32x4 S[NDT]; f32x4 dlog = (f32x4){0.f, 0.f, 0.f, 0.f};
    v4u stq[2], stg[2], stk, stv[2];
#define SCAN_TOK(stp_, tau_) (tok0 + 64 * (((stp_) >> 2) ? 3 - ((stp_) & 3) : ((stp_) & 3)) + (((stp_) >> 2) ? 63 - (tau_) : (tau_)))
#define SCAN_ISSUE(stp_) do { const int dir_ = (stp_) >> 2; const int gcol_ = HG ? ((dir_ ? PC_HFB : PC_HFF) + hh * 128) : ((dir_ ? PC_GGB : PC_GGF) + hh * 64); \
        _Pragma("unroll") for (int i_ = 0; i_ < PPR / 8; ++i_) { const int p_ = tid + 512 * i_, row_ = p_ / PPR, ch_ = p_ % PPR; const unsigned rb_ = (unsigned)(SCAN_TOK(stp_, row_) * NPROJ + 8 * ch_) * 2u; const char* Pc_ = (const char*)P; \
            if (PB) stq[i_] = LDT(Pc_ + (rb_ + (unsigned)(qc * 2))); stg[i_] = LDT(Pc_ + (rb_ + (unsigned)(gcol_ * 2))); if (!HG) stk = LDT(Pc_ + (rb_ + (unsigned)(kc * 2))); } \
        _Pragma("unroll") for (int i_ = 0; i_ < 2; ++i_) { const int p_ = tid + 512 * i_, row_ = p_ >> 4, ch_ = p_ & 15; stv[i_] = LDT((const char*)P + (unsigned)(SCAN_TOK(stp_, row_) * NPROJ + vc + 8 * ch_) * 2u); } } while (0)
#define SCAN_WRITE() do { \
        _Pragma("unroll") for (int i_ = 0; i_ < PPR / 8; ++i_) { const int p_ = tid + 512 * i_, row_ = p_ / PPR, ch_ = p_ % PPR; \
            if (PB) *(LAS v4u*)(lds + QT + row_ * RS + ch_ * 16) = stq[i_]; *(LAS v4u*)(lds + GT + row_ * RS + ch_ * 16) = stg[i_]; if (!HG) *(LAS v4u*)(lds + KT + row_ * RS + ch_ * 16) = stk; } \
        _Pragma("unroll") for (int i_ = 0; i_ < 2; ++i_) { const int p_ = tid + 512 * i_, row_ = p_ >> 4, ch_ = p_ & 15; *(LAS v4u*)(lds + VT + row_ * 272 + ch_ * 16) = stv[i_]; } } while (0)
    { SCAN_LANE() SCAN_ISSUE(0); }
    f32x4 okeep[4];
#pragma unroll
    for (int tm = 0; tm < 4; ++tm) okeep[tm] = (f32x4){0.f, 0.f, 0.f, 0.f};
    for (int stp = 0; stp < 8; ++stp) {
        const int dir = stp >> 2, ci = stp & 3;
        if (ci == 0) {
#pragma unroll
            for (int dt = 0; dt < NDT; ++dt) S[dt] = PB ? unpack4(((const v2u*)Ebuf)[e_index(unit, dir, w, NDT, dt, lane0)]) : (f32x4){0.f, 0.f, 0.f, 0.f};
            dlog = (f32x4){0.f, 0.f, 0.f, 0.f};
        }
        { SCAN_LANE() SCAN_WRITE(); }
        asm volatile("" ::: "memory");
        if (stp < 7) { SCAN_LANE() SCAN_ISSUE(stp + 1); }
        asm volatile("" ::: "memory");
        f32x4 o[4]; bf16 gate[16];
        if (PB) {
            SCAN_LANE()
#pragma unroll
            for (int tm = 0; tm < 4; ++tm) { o[tm] = (f32x4){0.f, 0.f, 0.f, 0.f};
                if (dir) {
                    if (3 - ci < NOFL) {
#pragma unroll
                        for (int e = 0; e < 4; ++e) o[tm][e] = bf1(*(const LAS bf16*)(lds + OFL + (3 - ci) * OFC + (63 - 4 * g) * 272 + (16 * w + c16) * 2 - (16 * tm + e) * 272));
                    } else {
#pragma unroll
                        for (int e = 0; e < 4; ++e) { float src_ = okeep[3 - tm][3 - e]; asm volatile("" : "+v"(src_)); o[tm][e] = __builtin_bit_cast(float, __builtin_amdgcn_ds_bpermute(((3 - g) * 16 + c16) << 2, __builtin_bit_cast(int, src_))); } } } }
            if (dir) {
#pragma unroll
                for (int tm = 0; tm < 4; ++tm)
#pragma unroll
                    for (int e = 0; e < 4; ++e) { const bf16* gp_ = (const bf16*)((const char*)P + ((unsigned)((SCAN_TOK(stp, 4 * g) * NPROJ + SCAN_GATEC) * 2) - (unsigned)((16 * tm + e) * NPROJ * 2))); gate[tm * 4 + e] = (fl & 4) ? __builtin_nontemporal_load(gp_) : *gp_; }
            }
        }
        __syncthreads();
        LAS unsigned char* vecb = lds + VEC + (stp & 1) * 1536;
        {
            SCAN_LANE()
            const s16x8 pat0 = tri_pat(g, c16, 0), pat1 = tri_pat(g, c16, 1);
            const int one2 = opq_v(0x3f803f80);
            const s16x8 ones = __builtin_bit_cast(s16x8, (v4u){(unsigned)one2, (unsigned)one2, (unsigned)one2, (unsigned)one2});
            s16x8 ga[2];
#pragma unroll
            for (int ks = 0; ks < 2; ++ks) ga[ks] = cat(vtr(lds + GT + (32 * ks + 8 * g + q4) * RS + (16 * cdt + 4 * p4) * 2), vtr(lds + GT + (32 * ks + 8 * g + 4 + q4) * RS + (16 * cdt + 4 * p4) * 2));
            const f32x4 z4 = (f32x4){0.f, 0.f, 0.f, 0.f};
            const f32x4 r = mma(ga[0], ones, z4), bl = mma(ga[1], ones, r);
#pragma unroll
            for (int ti = 0; ti < cntt; ++ti) { const int tt = ctt0 + ti;
                f32x4 bb;
                if (tt < 2) bb = mma(ga[0], (tt & 1) ? pat1 : pat0, z4); else bb = mma(ga[1], (tt & 1) ? pat1 : pat0, r);
                const int off = (16 * tt + c16) * RS + (16 * cdt + 4 * g) * 2;
                if (PB) {
                    const v2u qw = *(const LAS v2u*)(lds + QT + off);
                    const float e0 = EX2(bb[0] - r[0]), e1 = EX2(bb[1] - r[1]), e2 = EX2(bb[2] - r[2]), e3 = EX2(bb[3] - r[3]);
                    *(LAS v2u*)(lds + QT + off) = pack4(bflo(qw.x) * e0, bfhi(qw.x) * e1, bflo(qw.y) * e2, bfhi(qw.y) * e3);
                }
                float k0, k1, k2, k3;
                if (HG) { const v2u gw = *(const LAS v2u*)(lds + GT + off); k0 = 1.0f - EX2(bflo(gw.x)); k1 = 1.0f - EX2(bfhi(gw.x)); k2 = 1.0f - EX2(bflo(gw.y)); k3 = 1.0f - EX2(bfhi(gw.y)); }
                else { const v2u kw = *(const LAS v2u*)(lds + KT + off); k0 = bflo(kw.x); k1 = bfhi(kw.x); k2 = bflo(kw.y); k3 = bfhi(kw.y); }
                const f32x4 ref = PB ? r : bl;
                *(LAS v2u*)(lds + KT + off) = pack4(k0 * EX2(ref[0] - bb[0]), k1 * EX2(ref[1] - bb[1]), k2 * EX2(ref[2] - bb[2]), k3 * EX2(ref[3] - bb[3]));
            }
            if (c16 == 0 && (HG || (w & 1) == 0)) {
                LAS f32x4* vp = (LAS f32x4*)(vecb + (16 * cdt + 4 * g) * 4);
                vp[0] = (f32x4){EX2(r[0]), EX2(r[1]), EX2(r[2]), EX2(r[3])};
                vp[32] = (f32x4){EX2(bl[0]), EX2(bl[1]), EX2(bl[2]), EX2(bl[3])};
                vp[64] = (f32x4){EX2(bl[0] - r[0]), EX2(bl[1] - r[1]), EX2(bl[2] - r[2]), EX2(bl[3] - r[3])};
            }
            dlog += bl;
        }
        __syncthreads();
        if (PB) {
            { SCAN_LANE()
#pragma unroll
            for (int ii = 0; ii < 2; ++ii) { const int idx = 2 * w + ii, sn = idx >> 2, tm = idx & 3;
                v2u wv = (v2u){0u, 0u};
                if (sn <= tm) {
                    f32x4 a = (f32x4){0.f, 0.f, 0.f, 0.f};
#pragma unroll
                    for (int ks = 0; ks < NKS; ++ks) a = mma(*(const LAS s16x8*)(lds + KT + (16 * sn + c16) * RS + (32 * ks + 8 * g) * 2), *(const LAS s16x8*)(lds + QT + (16 * tm + c16) * RS + (32 * ks + 8 * g) * 2), a);
                    if (sn == tm) {
#pragma unroll
                        for (int e = 0; e < 4; ++e) a[e] = (4 * g + e <= c16) ? a[e] : 0.f;
                    }
                    wv = pack4(a[0], a[1], a[2], a[3]);
                }
                *(LAS v2u*)(lds + AT + (16 * tm + c16) * 144 + (16 * sn + 4 * g) * 2) = wv;
            } }
        }
        {
            SCAN_LANE()
            s16x8 vf[2];
#pragma unroll
            for (int ks = 0; ks < 2; ++ks) vf[ks] = cat(vtr(lds + VT + (32 * ks + 8 * g + q4) * 272 + (16 * w + 4 * p4) * 2), vtr(lds + VT + (32 * ks + 8 * g + 4 + q4) * 272 + (16 * w + 4 * p4) * 2));
            if (PB) {
#pragma unroll
                for (int ks = 0; ks < NKS; ++ks) {
                    const f32x4 e0 = *(const LAS f32x4*)(vecb + (32 * ks + 4 * g) * 4), e1 = *(const LAS f32x4*)(vecb + (32 * ks + 16 + 4 * g) * 4);
                    const f32x4 s0 = S[2 * ks] * e0, s1 = S[2 * ks + 1] * e1;
                    const v2u lo = pack4(s0[0], s0[1], s0[2], s0[3]), hi = pack4(s1[0], s1[1], s1[2], s1[3]);
                    const s16x8 bS = __builtin_bit_cast(s16x8, (v4u){lo.x, lo.y, hi.x, hi.y});
#pragma unroll
                    for (int tm = 0; tm < 4; ++tm) { const LAS unsigned char* qp = lds + QT + (16 * tm + c16) * RS + (32 * ks + 4 * g) * 2;
                        const v2u a0 = *(const LAS v2u*)qp, a1 = *(const LAS v2u*)(qp + 32);
                        o[tm] = mma(__builtin_bit_cast(s16x8, (v4u){a0.x, a0.y, a1.x, a1.y}), bS, o[tm]); }
                }
            }
#pragma unroll
            for (int dt = 0; dt < NDT; ++dt) {
                f32x4 U = (f32x4){0.f, 0.f, 0.f, 0.f};
#pragma unroll
                for (int ks = 0; ks < 2; ++ks) U = mma(cat(vtr(lds + KT + (32 * ks + 8 * g + q4) * RS + (16 * dt + 4 * p4) * 2), vtr(lds + KT + (32 * ks + 8 * g + 4 + q4) * RS + (16 * dt + 4 * p4) * 2)), vf[ks], U);
                const f32x4 el = *(const LAS f32x4*)(vecb + 512 + (16 * dt + 4 * g) * 4);
                if (PB) { const f32x4 elr = *(const LAS f32x4*)(vecb + 1024 + (16 * dt + 4 * g) * 4); S[dt] = el * S[dt] + elr * U; }
                else S[dt] = el * S[dt] + U;
            }
            if (PB) {
                __syncthreads();
#pragma unroll
                for (int tm = 0; tm < 4; ++tm)
#pragma unroll
                    for (int ks = 0; ks <= (tm >> 1); ++ks) o[tm] = mma(*(const LAS s16x8*)(lds + AT + (16 * tm + c16) * 144 + (32 * ks + 8 * g) * 2), vf[ks], o[tm]);
            }
        }
        if (PB) {
            SCAN_LANE()
            if (dir == 0) {
#pragma unroll
                for (int tm = 0; tm < 4; ++tm) {
                    if (ci < NOFL) {
#pragma unroll
                        for (int e = 0; e < 4; ++e) *(LAS bf16*)(lds + OFL + ci * OFC + (4 * g) * 272 + (16 * w + c16) * 2 + (16 * tm + e) * 272) = (bf16)pg8::cvt_pk_bf16(o[tm][e], 0.f);
                    } else okeep[tm] = o[tm]; }
                __syncthreads();
            } else {
#pragma unroll
                for (int tm = 0; tm < 4; ++tm) { f32x4 sq = o[tm] * o[tm];
#pragma unroll
                    for (int e = 0; e < 4; ++e) sq[e] = row16_sum(sq[e]);
                    if (c16 == 0) {
#pragma unroll
                        for (int e = 0; e < 4; ++e) *(LAS float*)(lds + HN + ((16 * tm + 4 * g + e) * 8 + w) * 4) = sq[e]; }
                }
                __syncthreads();
                const float wv = onw[16 * w + c16];
#pragma unroll
                for (int tm = 0; tm < 4; ++tm) { asm volatile("" ::: "memory");
#pragma unroll
                    for (int e = 0; e < 4; ++e) { const int tau = 16 * tm + 4 * g + e; const f32x4 h0 = *(const LAS f32x4*)(lds + HN + tau * 32), h1 = *(const LAS f32x4*)(lds + HN + tau * 32 + 16);
                        const f32x4 h4 = h0 + h1; const pg8::f32x2_t h2 = __builtin_shufflevector(h4, h4, 0, 1) + __builtin_shufflevector(h4, h4, 2, 3);
                        const float tot = h2[0] + h2[1]; const float rn = __builtin_amdgcn_rsqf(tot * (1.0f / 128.0f) + HEAD_EPS);
                        *(bf16*)((char*)Y + ((unsigned)((SCAN_TOK(stp, 4 * g) * D + SCAN_YCOL) * 2) - (unsigned)((16 * tm + e) * D * 2))) = (bf16)pg8::cvt_pk_bf16(o[tm][e] * rn * wv * bf1(gate[tm * 4 + e]), 0.f); } }
            }
        } else {
            if (ci == 3) {
                SCAN_LANE()
#pragma unroll
                for (int dt = 0; dt < NDT; ++dt) ((v2u*)Ebuf)[e_index(unit, dir, w, NDT, dt, lane0)] = pack4(S[dt][0], S[dt][1], S[dt][2], S[dt][3]);
                if (c16 == 0 && (HG || (w & 1) == 0)) *(f32x4*)(Dbuf + d_index(HG ? 1 : 0, seq, dir, seg, 16 * cdt + 4 * g)) = (f32x4){EX2(dlog[0]), EX2(dlog[1]), EX2(dlog[2]), EX2(dlog[3])};
            }
            __syncthreads();
        }
    }
#undef SCAN_LANE
#undef SCAN_GATEC
#undef SCAN_YCOL
#undef SCAN_TOK
#undef SCAN_ISSUE
#undef SCAN_WRITE
#undef LDT
}
template <int DK, bool HG, bool PB, int LB, int HNO> struct Strm {
    static constexpr int RS = DK * 2 + 16, NDT = DK / 16, NKS = DK / 32, PPR = DK / 8;
    static constexpr int QT = LB, GT = LB + 64 * RS, KT = LB + 2 * 64 * RS, VT = LB + 3 * 64 * RS, AT = GT, VEC = VT + 64 * 272, END = VEC + 2 * 1536, HN = HNO;
    static_assert(64 * 144 <= 64 * RS, "score tile fits in the decay tile");
    f32x4 S[NDT]; f32x4 dlog; v4u stq[2], stg[2], stk, stv[2]; f32x4 o[4], ofw[4]; bf16 gate[16]; s16x8 vf[2];
    int hh, tok0, unit, w, lane0, layer; LAS unsigned char* lds;
#define ST_P ((const bf16*)(kargs()->ws + WS_BIG))
#define ST_OF ((float*)(kargs()->ws + WS_YS))
#define ST_E ((f32x4*)(kargs()->ws + WS_XG + (HG ? E_H_OFF : E_G_OFF)))
#define ST_D ((float*)(kargs()->ws + WS_XG + D_OFF))
#define ST_Y ((bf16*)(kargs()->ws + WS_Y))
#define SCAN_LANE() const int ln_ = opq_v(lane0), g = ln_ >> 4, c16 = ln_ & 15, q4 = c16 >> 2, p4 = c16 & 3, tid = w * 64 + ln_; (void)g; (void)c16; (void)q4; (void)p4; (void)tid;
#define SCAN_GATEC ((HG ? PC_HR : PC_GR) + hh * 128 + 16 * w + c16)
#define SCAN_YCOL ((HG ? 512 : 0) + hh * 128 + 16 * w + c16)
#define SCAN_TOK(stp_, tau_) (tok0 + 64 * (((stp_) >> 2) ? 3 - ((stp_) & 3) : ((stp_) & 3)) + (((stp_) >> 2) ? 63 - (tau_) : (tau_)))
    __device__ __forceinline__ void issue(int stp, int tid) {
        const int qc = HG ? PC_HQ + hh * 128 : PC_GQ + hh * 64, kc = PC_GK + hh * 64, vc = (HG ? PC_HV : PC_GV) + hh * 128;
        const int dir_ = stp >> 2; const int gcol_ = HG ? ((dir_ ? PC_HFB : PC_HFF) + hh * 128) : ((dir_ ? PC_GGB : PC_GGF) + hh * 64); const char* Pc_ = (const char*)ST_P;
#pragma unroll
        for (int i_ = 0; i_ < PPR / 8; ++i_) { const int p_ = tid + 512 * i_, row_ = p_ / PPR, ch_ = p_ % PPR; const unsigned rb_ = (unsigned)(SCAN_TOK(stp, row_) * NPROJ + 8 * ch_) * 2u;
            if (PB) stq[i_] = *(const v4u*)(Pc_ + (rb_ + (unsigned)(qc * 2))); stg[i_] = *(const v4u*)(Pc_ + (rb_ + (unsigned)(gcol_ * 2))); if (!HG) stk = *(const v4u*)(Pc_ + (rb_ + (unsigned)(kc * 2))); }
#pragma unroll
        for (int i_ = 0; i_ < 2; ++i_) { const int p_ = tid + 512 * i_, row_ = p_ >> 4, ch_ = p_ & 15; stv[i_] = *(const v4u*)(Pc_ + (unsigned)(SCAN_TOK(stp, row_) * NPROJ + vc + 8 * ch_) * 2u); }
    }
    __device__ __forceinline__ void init(int unit_, int layer_, LAS unsigned char* lds_, int w_, int lane_) {
        unit = unit_; layer = layer_; lds = lds_; w = w_; lane0 = lane_;
        const int seq = unit >> 5, seg = unit & 31, b = seq >> 2; hh = seq & 3; tok0 = b * SEQ + seg * 256;
        dlog = (f32x4){0.f, 0.f, 0.f, 0.f};
        { SCAN_LANE() issue(0, tid); }
    }
    __device__ __forceinline__ void pre(int stp) {
        const int dir = stp >> 2, ci = stp & 3;
        if (ci == 0) {
#pragma unroll
            for (int dt = 0; dt < NDT; ++dt) S[dt] = PB ? unpack4(((const v2u*)ST_E)[e_index(unit, dir, w, NDT, dt, lane0)]) : (f32x4){0.f, 0.f, 0.f, 0.f};
            dlog = (f32x4){0.f, 0.f, 0.f, 0.f};
        }
        { SCAN_LANE()
#pragma unroll
          for (int i_ = 0; i_ < PPR / 8; ++i_) { const int p_ = tid + 512 * i_, row_ = p_ / PPR, ch_ = p_ % PPR;
              if (PB) *(LAS v4u*)(lds + QT + row_ * RS + ch_ * 16) = stq[i_]; *(LAS v4u*)(lds + GT + row_ * RS + ch_ * 16) = stg[i_]; if (!HG) *(LAS v4u*)(lds + KT + row_ * RS + ch_ * 16) = stk; }
#pragma unroll
          for (int i_ = 0; i_ < 2; ++i_) { const int p_ = tid + 512 * i_, row_ = p_ >> 4, ch_ = p_ & 15; *(LAS v4u*)(lds + VT + row_ * 272 + ch_ * 16) = stv[i_]; } }
        asm volatile("" ::: "memory");
        if (stp < 7) { SCAN_LANE() issue(stp + 1, tid); }
        asm volatile("" ::: "memory");
    }
    __device__ __forceinline__ void stC(int stp) {
        LAS unsigned char* vecb = lds + VEC + (stp & 1) * 1536;
        const int cdt = HG ? w : (w >> 1), ctt0 = HG ? 0 : 2 * (w & 1), cntt = HG ? 4 : 2;
        SCAN_LANE()
        const s16x8 pat0 = tri_pat(g, c16, 0), pat1 = tri_pat(g, c16, 1);
        const int one2 = opq_v(0x3f803f80);
        const s16x8 ones = __builtin_bit_cast(s16x8, (v4u){(unsigned)one2, (unsigned)one2, (unsigned)one2, (unsigned)one2});
        s16x8 ga[2];
#pragma unroll
        for (int ks = 0; ks < 2; ++ks) ga[ks] = cat(vtr(lds + GT + (32 * ks + 8 * g + q4) * RS + (16 * cdt + 4 * p4) * 2), vtr(lds + GT + (32 * ks + 8 * g + 4 + q4) * RS + (16 * cdt + 4 * p4) * 2));
        const f32x4 z4 = (f32x4){0.f, 0.f, 0.f, 0.f};
        const f32x4 r = mma(ga[0], ones, z4), bl = mma(ga[1], ones, r);
#pragma unroll
        for (int ti = 0; ti < cntt; ++ti) { const int tt = ctt0 + ti;
            f32x4 bb;
            if (tt < 2) bb = mma(ga[0], (tt & 1) ? pat1 : pat0, z4); else bb = mma(ga[1], (tt & 1) ? pat1 : pat0, r);
            const int off = (16 * tt + c16) * RS + (16 * cdt + 4 * g) * 2;
            if (PB) {
                const v2u qw = *(const LAS v2u*)(lds + QT + off);
                const float e0 = EX2(bb[0] - r[0]), e1 = EX2(bb[1] - r[1]), e2 = EX2(bb[2] - r[2]), e3 = EX2(bb[3] - r[3]);
                *(LAS v2u*)(lds + QT + off) = pack4(bflo(qw.x) * e0, bfhi(qw.x) * e1, bflo(qw.y) * e2, bfhi(qw.y) * e3);
            }
            float k0, k1, k2, k3;
            if (HG) { const v2u gw = *(const LAS v2u*)(lds + GT + off); k0 = 1.0f - EX2(bflo(gw.x)); k1 = 1.0f - EX2(bfhi(gw.x)); k2 = 1.0f - EX2(bflo(gw.y)); k3 = 1.0f - EX2(bfhi(gw.y)); }
            else { const v2u kw = *(const LAS v2u*)(lds + KT + off); k0 = bflo(kw.x); k1 = bfhi(kw.x); k2 = bflo(kw.y); k3 = bfhi(kw.y); }
            const f32x4 ref = PB ? r : bl;
            *(LAS v2u*)(lds + KT + off) = pack4(k0 * EX2(ref[0] - bb[0]), k1 * EX2(ref[1] - bb[1]), k2 * EX2(ref[2] - bb[2]), k3 * EX2(ref[3] - bb[3]));
        }
        if (c16 == 0 && (HG || (w & 1) == 0)) {
            LAS f32x4* vp = (LAS f32x4*)(vecb + (16 * cdt + 4 * g) * 4);
            vp[0] = (f32x4){EX2(r[0]), EX2(r[1]), EX2(r[2]), EX2(r[3])};
            vp[32] = (f32x4){EX2(bl[0]), EX2(bl[1]), EX2(bl[2]), EX2(bl[3])};
            vp[64] = (f32x4){EX2(bl[0] - r[0]), EX2(bl[1] - r[1]), EX2(bl[2] - r[2]), EX2(bl[3] - r[3])};
        }
        dlog += bl;
    }
    __device__ __forceinline__ void stS(int stp) {
        SCAN_LANE()
#pragma unroll
        for (int ii = 0; ii < 2; ++ii) { const int idx = 2 * w + ii, sn = idx >> 2, tm = idx & 3;
            v2u wv = (v2u){0u, 0u};
            if (sn <= tm) {
                f32x4 a = (f32x4){0.f, 0.f, 0.f, 0.f};
#pragma unroll
                for (int ks = 0; ks < NKS; ++ks) a = mma(*(const LAS s16x8*)(lds + KT + (16 * sn + c16) * RS + (32 * ks + 8 * g) * 2), *(const LAS s16x8*)(lds + QT + (16 * tm + c16) * RS + (32 * ks + 8 * g) * 2), a);
                if (sn == tm) {
#pragma unroll
                    for (int e = 0; e < 4; ++e) a[e] = (4 * g + e <= c16) ? a[e] : 0.f;
                }
                wv = pack4(a[0], a[1], a[2], a[3]);
            }
            *(LAS v2u*)(lds + AT + (16 * tm + c16) * 144 + (16 * sn + 4 * g) * 2) = wv;
        }
    }
    __device__ __forceinline__ void stO1(int stp) {
        const int dir = stp >> 2;
        LAS unsigned char* vecb = lds + VEC + (stp & 1) * 1536;
        SCAN_LANE()
        if (PB && dir) {
#pragma unroll
            for (int tm = 0; tm < 4; ++tm)
#pragma unroll
                for (int e = 0; e < 4; ++e) ofw[tm][e] = *(const float*)((const char*)ST_OF + ((unsigned)((SCAN_TOK(stp, 4 * g) * D + SCAN_YCOL) * 4) - (unsigned)((16 * tm + e) * D * 4)));
#pragma unroll
            for (int tm = 0; tm < 4; ++tm)
#pragma unroll
                for (int e = 0; e < 4; ++e) gate[tm * 4 + e] = *(const bf16*)((const char*)ST_P + ((unsigned)((SCAN_TOK(stp, 4 * g) * NPROJ + SCAN_GATEC) * 2) - (unsigned)((16 * tm + e) * NPROJ * 2)));
        }
#pragma unroll
        for (int ks = 0; ks < 2; ++ks) vf[ks] = cat(vtr(lds + VT + (32 * ks + 8 * g + q4) * 272 + (16 * w + 4 * p4) * 2), vtr(lds + VT + (32 * ks + 8 * g + 4 + q4) * 272 + (16 * w + 4 * p4) * 2));
        if (PB) {
#pragma unroll
            for (int tm = 0; tm < 4; ++tm) o[tm] = (f32x4){0.f, 0.f, 0.f, 0.f};
#pragma unroll
            for (int ks = 0; ks < NKS; ++ks) {
                const f32x4 e0 = *(const LAS f32x4*)(vecb + (32 * ks + 4 * g) * 4), e1 = *(const LAS f32x4*)(vecb + (32 * ks + 16 + 4 * g) * 4);
                const f32x4 s0 = S[2 * ks] * e0, s1 = S[2 * ks + 1] * e1;
                const v2u lo = pack4(s0[0], s0[1], s0[2], s0[3]), hi = pack4(s1[0], s1[1], s1[2], s1[3]);
                const s16x8 bS = __builtin_bit_cast(s16x8, (v4u){lo.x, lo.y, hi.x, hi.y});
#pragma unroll
                for (int tm = 0; tm < 4; ++tm) { const LAS unsigned char* qp = lds + QT + (16 * tm + c16) * RS + (32 * ks + 4 * g) * 2;
                    const v2u a0 = *(const LAS v2u*)qp, a1 = *(const LAS v2u*)(qp + 32);
                    o[tm] = mma(__builtin_bit_cast(s16x8, (v4u){a0.x, a0.y, a1.x, a1.y}), bS, o[tm]); }
            }
        }
#pragma unroll
        for (int dt = 0; dt < NDT; ++dt) {
            f32x4 U = (f32x4){0.f, 0.f, 0.f, 0.f};
#pragma unroll
            for (int ks = 0; ks < 2; ++ks) U = mma(cat(vtr(lds + KT + (32 * ks + 8 * g + q4) * RS + (16 * dt + 4 * p4) * 2), vtr(lds + KT + (32 * ks + 8 * g + 4 + q4) * RS + (16 * dt + 4 * p4) * 2)), vf[ks], U);
            const f32x4 el = *(const LAS f32x4*)(vecb + 512 + (16 * dt + 4 * g) * 4);
            if (PB) { const f32x4 elr = *(const LAS f32x4*)(vecb + 1024 + (16 * dt + 4 * g) * 4); S[dt] = el * S[dt] + elr * U; }
            else S[dt] = el * S[dt] + U;
        }
    }
    __device__ __forceinline__ void stO2(int stp) {
        SCAN_LANE()
#pragma unroll
        for (int tm = 0; tm < 4; ++tm)
#pragma unroll
            for (int ks = 0; ks <= (tm >> 1); ++ks) o[tm] = mma(*(const LAS s16x8*)(lds + AT + (16 * tm + c16) * 144 + (32 * ks + 8 * g) * 2), vf[ks], o[tm]);
    }
    __device__ __forceinline__ void fin0(int stp) {
        SCAN_LANE()
#pragma unroll
        for (int tm = 0; tm < 4; ++tm)
#pragma unroll
            for (int e = 0; e < 4; ++e) *(float*)((char*)ST_OF + ((unsigned)((SCAN_TOK(stp, 4 * g) * D + SCAN_YCOL) * 4) + (unsigned)((16 * tm + e) * D * 4))) = o[tm][e];
    }
    __device__ __forceinline__ void fin1a(int stp) {
        SCAN_LANE()
#pragma unroll
        for (int tm = 0; tm < 4; ++tm) { o[tm] += ofw[tm]; f32x4 sq = o[tm] * o[tm];
#pragma unroll
            for (int e = 0; e < 4; ++e) sq[e] = row16_sum(sq[e]);
            if (c16 == 0) {
#pragma unroll
                for (int e = 0; e < 4; ++e) *(LAS float*)(lds + HN + ((16 * tm + 4 * g + e) * 8 + w) * 4) = sq[e]; }
        }
    }
    __device__ __forceinline__ void fin1b(int stp) {
        SCAN_LANE()
        const float wv = (kargs()->in[HG ? I_HON : I_GON] + layer * 128)[16 * w + c16];
#pragma unroll
        for (int tm = 0; tm < 4; ++tm) { asm volatile("" ::: "memory");
#pragma unroll
            for (int e = 0; e < 4; ++e) { const int tau = 16 * tm + 4 * g + e; const f32x4 h0 = *(const LAS f32x4*)(lds + HN + tau * 32), h1 = *(const LAS f32x4*)(lds + HN + tau * 32 + 16);
                const f32x4 h4 = h0 + h1; const pg8::f32x2_t h2 = __builtin_shufflevector(h4, h4, 0, 1) + __builtin_shufflevector(h4, h4, 2, 3);
                const float tot = h2[0] + h2[1]; const float rn = __builtin_amdgcn_rsqf(tot * (1.0f / 128.0f) + HEAD_EPS);
                *(bf16*)((char*)ST_Y + ((unsigned)((SCAN_TOK(stp, 4 * g) * D + SCAN_YCOL) * 2) - (unsigned)((16 * tm + e) * D * 2))) = (bf16)pg8::cvt_pk_bf16(o[tm][e] * rn * wv * bf1(gate[tm * 4 + e]), 0.f); } }
    }
    __device__ __forceinline__ void finA(int dir) {
        const int cdt = HG ? w : (w >> 1); const int seq = unit >> 5, seg = unit & 31;
        SCAN_LANE()
#pragma unroll
        for (int dt = 0; dt < NDT; ++dt) ((v2u*)ST_E)[e_index(unit, dir, w, NDT, dt, lane0)] = pack4(S[dt][0], S[dt][1], S[dt][2], S[dt][3]);
        if (c16 == 0 && (HG || (w & 1) == 0)) *(f32x4*)(ST_D + d_index(HG ? 1 : 0, seq, dir, seg, 16 * cdt + 4 * g)) = (f32x4){EX2(dlog[0]), EX2(dlog[1]), EX2(dlog[2]), EX2(dlog[3])};
    }
#undef SCAN_LANE
#undef SCAN_GATEC
#undef SCAN_YCOL
#undef SCAN_TOK
#undef ST_P
#undef ST_OF
#undef ST_E
#undef ST_D
#undef ST_Y
};
constexpr int PAIR_G_LB = 0, PAIR_H_LB = 3 * 64 * 144 + 64 * 272 + 3072, PAIR_HN_G = PAIR_H_LB + 3 * 64 * 272 + 64 * 272 + 3072, PAIR_HN_H = PAIR_HN_G + 2048;
static_assert(PAIR_HN_H + 2048 <= 131072, "pair LDS map");
template <bool PB> __device__ __forceinline__ void scan_pair(int unit, int layer, LAS unsigned char* lds, int w, int lane) {
    Strm<64, false, PB, PAIR_G_LB, PAIR_HN_G> Gs; Strm<128, true, PB, PAIR_H_LB, PAIR_HN_H> Hs;
    static_assert(Strm<64, false, PB, PAIR_G_LB, PAIR_HN_G>::END <= PAIR_H_LB && Strm<128, true, PB, PAIR_H_LB, PAIR_HN_H>::END <= PAIR_HN_G, "pair LDS map");
    Gs.init(unit, layer, lds, w, lane); Hs.init(unit, layer, lds, w, lane);
    for (int stp = 0; stp < 8; ++stp) {
        const int dir = stp >> 2, ci = stp & 3;
        Gs.pre(stp); Hs.pre(stp);
        __syncthreads();
        Gs.stC(stp); Hs.stC(stp);
        __syncthreads();
        if (PB) { Gs.stS(stp); Hs.stS(stp); }
        Gs.stO1(stp); Hs.stO1(stp);
        if (PB) {
            __syncthreads();
            Gs.stO2(stp); Hs.stO2(stp);
            if (dir == 0) { Gs.fin0(stp); Hs.fin0(stp); if (ci == 3) VM_WAIT(); __syncthreads(); }
            else { Gs.fin1a(stp); Hs.fin1a(stp); __syncthreads(); Gs.fin1b(stp); Hs.fin1b(stp); }
        } else { if (ci == 3) { Gs.finA(dir); Hs.finA(dir); } __syncthreads(); }
    }
}
}

#define WSP(T, off) ((T*)(A->ws + (off)))
#define FILLER(U_, lo_, hi_) do { int rem_ = opq_s(U_) % G; if (2 * (G - rem_) < G) rem_ = 0;     \
    if (rem_ == 0 || bx >= rem_) { const int P_ = rem_ == 0 ? G : G - rem_, r_ = rem_ == 0 ? bx : bx - rem_; \
        convert_descs(A, (lo_), (hi_), r_ * NWAVES + wave, P_ * NWAVES, (LAS float*)(lds + RING_OFF + wave * 16384), lane_id()); } } while (0)
#define PP_TAIL(U_) do { int rem_ = opq_s(U_) % G; if (2 * (G - rem_) < G) rem_ = 0; if (rem_ == 0 || bx >= rem_) { const int P_ = rem_ == 0 ? G : G - rem_, r_ = rem_ == 0 ? bx : bx - rem_; \
        pg8::Gemm gp_{WSP(bf16, WS_PB) + (size_t)layer * M * PLE, WSP(bf16, WS_WPP) + (size_t)layer * D * PLE, PLE}; pg8::StaticOrder Sp_; Sp_.init(M, D, P_, r_); EpiBf16Plain Ep_{WSP(bf16, WS_PP)}; \
        pg8::gemm_phase<EpiBf16Plain, pg8::StaticOrder, true, true>(lds + RING_OFF, gp_, Sp_, Ep_, wave); } } while (0)
#define SSP(site) (WSP(float, WS_SSP) + (size_t)((site) % 3) * M * 16)
#define PH_LOCALS KArgs A = kargs(); const int G = opq_s(gridDim.x), bx = opq_s(blockIdx.x), wave = opq_s(wave_s), lane = lane_id(), tid = wave * 64 + lane; const int vcu = (G % 8 == 0) ? (bx % 8) * (G / 8) + bx / 8 : bx; const int gw = vcu * NWAVES + wave, NGW = G * NWAVES; (void)A; (void)lane; (void)gw; (void)NGW; (void)tid;
__global__ void __launch_bounds__(NWAVES * 64, 2) mk_fwd(Args args_unused) {
    extern __shared__ __attribute__((aligned(16))) unsigned char lds_raw[];
    LAS unsigned char* lds = (LAS unsigned char*)lds_raw;
    for (int u = threadIdx.x; u < (LDS_BYTES - LDSCTL_OFF) / 4; u += NWAVES * 64) ((LAS unsigned*)(lds + LDSCTL_OFF))[u] = 0u;
    __syncthreads();
    const int wave_s = __builtin_amdgcn_readfirstlane(threadIdx.x >> 6);
    int lo, hi;
    { KArgs A = kargs(); lo = A->ph_lo; hi = A->ph_hi;
#if !MK_MULTI
      (void)xcd_barrier_post(WSP(unsigned, WS_CTL) + CW_BAR, (volatile LAS unsigned*)(lds + MISC_OFF) + 8);
#endif
    }
    int ph = 0;
#define IN_PH (lo <= ph && ph < hi)
#if MK_MULTI
#define SEAM do { ++ph; } while (0)
#else
#define SEAM do { if (lo <= ph && ph + 1 < hi) { KArgs A_ = kargs(); XcdBarrier bar_; bar_.bar = (unsigned*)(A_->ws + WS_CTL) + CW_BAR; bar_.x = xb_xcc_id(); bar_.st = (volatile LAS unsigned*)(lds + MISC_OFF) + 8; xcd_barrier(bar_); } ++ph; } while (0)
#endif

    for (int rep = 0; rep < REP_PRO; ++rep) { if (rep) --ph;
    if (IN_PH) {
        PH_LOCALS
        bf16* HB = WSP(bf16, WS_HBX); float* SS = SSP(0); float* lbt = WSP(float, WS_TAB + TAB_LB);
        LAS float* scr = (LAS float*)(lds + RING_OFF + wave * 16384);
        convert_descs(A, 0, 10, gw, NGW, scr, lane);
        convert_descs(A, 20, 23, gw, NGW, scr, lane);
        convert_descs(A, 26, 35, gw, NGW, scr, lane);
        for (int it = gw; it < 8 * 16 * 8; it += NGW) { const int mat = it / 128, kb = (it % 128) / 8, nb = it % 8, i = mat >> 1, dd = mat & 1, k0 = 64 * kb, n = 32 * nb + (lane & 31);
            const float* wl = A->in[I_WIN] + (size_t)i * D * DIN + 1536 + 16 * dd; const float* g2 = A->in[I_WG2] + (size_t)(i * 2 + dd) * 16 * 256 + n; const float* nm = A->in[I_NMIX] + i * D;
            LAS float* wls = scr + 64 * 33;
            { const f32x4* wr4 = (const f32x4*)(wl + (size_t)(k0 + lane) * DIN); const f32x4 w0 = wr4[0], w1 = wr4[1], w2 = wr4[2], w3 = wr4[3]; const float sc = nm[k0 + lane];
              LAS f32x4* d4 = (LAS f32x4*)(wls + lane * 20); d4[0] = w0 * sc; d4[1] = w1 * sc; d4[2] = w2 * sc; d4[3] = w3 * sc; }
            float gr[16];
#pragma unroll
            for (int r = 0; r < 16; ++r) gr[r] = g2[r * 256];
            LDS_WAIT(); asm volatile("" ::: "memory");
#pragma unroll 4
            for (int q = 0; q < 32; ++q) { const int kk = 2 * q + (lane >> 5); const LAS f32x4* w4 = (const LAS f32x4*)(wls + kk * 20); const f32x4 a0 = w4[0], a1 = w4[1], a2 = w4[2], a3 = w4[3];
                float s = (a0[0] * gr[0] + a0[1] * gr[1]) + (a0[2] * gr[2] + a0[3] * gr[3]); s += (a1[0] * gr[4] + a1[1] * gr[5]) + (a1[2] * gr[6] + a1[3] * gr[7]);
                s += (a2[0] * gr[8] + a2[1] * gr[9]) + (a2[2] * gr[10] + a2[3] * gr[11]); s += (a3[0] * gr[12] + a3[1] * gr[13]) + (a3[2] * gr[14] + a3[3] * gr[15]);
                scr[kk * 33 + (lane & 31)] = s; }
            tr_writeout(WSP(bf16, WS_WIN) + (size_t)i * NPROJ * D, D, 4096 + 256 * dd + 32 * (4 * (nb & 1) + (nb >> 1)), k0, scr, lane);
        }
        for (int m0 = gw; m0 < M; m0 += 4 * NGW) { f32x4 xv[4][4];
#pragma unroll
            for (int r = 0; r < 4; ++r) { const int m = m0 + r * NGW; if (m < M) { const f32x4* xr = (const f32x4*)(A->in[I_X] + (size_t)m * D) + lane;
#pragma unroll
                for (int j = 0; j < 4; ++j) xv[r][j] = __builtin_nontemporal_load(xr + 64 * j); } }
#pragma unroll
            for (int r = 0; r < 4; ++r) { const int m = m0 + r * NGW; if (m < M) { v2u* br = (v2u*)(HB + (size_t)m * D) + lane; float s = 0.f;
#pragma unroll
                for (int j = 0; j < 4; ++j) { const f32x4 v = xv[r][j]; v2u w; w.x = pk2(v[0], v[1]); w.y = pk2(v[2], v[3]); br[64 * j] = w; const float r0 = bflo(w.x), r1 = bfhi(w.x), r2 = bflo(w.y), r3 = bfhi(w.y); s += (r0 * r0 + r1 * r1) + (r2 * r2 + r3 * r3); }
                s = wave_sum(s, lane); if (lane < 16) SS[(size_t)m * 16 + lane] = lane == 0 ? s : 0.f; } } }
        { const size_t n4 = (size_t)DEPTH * M * PLE / 4; const f32x4* src = (const f32x4*)A->in[I_P]; v2u* dst = WSP(v2u, WS_PB);
          const size_t st = (size_t)G * 512;
          for (size_t i0 = (size_t)bx * 512 + tid; i0 < n4; i0 += 8 * st) { f32x4 v[8];
#pragma unroll
              for (int j = 0; j < 8; ++j) if (i0 + j * st < n4) v[j] = __builtin_nontemporal_load(src + i0 + j * st);
#pragma unroll
              for (int j = 0; j < 8; ++j) if (i0 + j * st < n4) { v2u w; w.x = pk2(v[j][0], v[j][1]); w.y = pk2(v[j][2], v[j][3]); __builtin_nontemporal_store(w, dst + i0 + j * st); } } }
        for (int i = bx * 512 + tid; i < 1024; i += G * 512) { const float* l = A->in[I_LBL]; float z0 = l[i], z1 = l[1024 + i], z2 = l[2048 + i], z3 = l[3072 + i];
            const float mx = fmaxf(fmaxf(z0, z1), fmaxf(z2, z3)); z0 = __expf(z0 - mx); z1 = __expf(z1 - mx); z2 = __expf(z2 - mx); z3 = __expf(z3 - mx);
            const float inv = 1.0f / (z0 + z1 + z2 + z3);
            lbt[i] = 0.f; lbt[1024 + i] = z1 * inv; lbt[2048 + i] = (z1 + z2) * inv; lbt[3072 + i] = (z1 + z2 + z3) * inv; }
    }
    SEAM; }

    for (int layer = 0; layer < DEPTH; ++layer) {
        for (int rep = 0; rep < REP_G1; ++rep) { if (rep) --ph;
        if (IN_PH) {
            PH_LOCALS
            pg8::Gemm g{WSP(bf16, WS_HBX), WSP(bf16, WS_WIN) + (size_t)layer * NPROJ * D, D}; pg8::StaticOrder S; S.init(M, NPROJ, G, bx);
            fill_rs_table((LAS float*)(lds + RSTAB_OFF), S, SSP(layer * 3), nullptr, 1.0f, tid);
            EpiProj E{WSP(bf16, WS_BIG), (const LAS float*)(lds + RSTAB_OFF), WSP(float, WS_TAB + TAB_LB) + layer * 1024, A->in[I_BG] + layer * 512};
            pg8::gemm_phase<EpiProj, pg8::StaticOrder, true, true>(lds + RING_OFF, g, S, E, wave);
            if (rep == 0 && layer == 0) FILLER(S.nwg, 35, 40);
            if (rep == 0 && layer == 1) FILLER(S.nwg, 45, 50);
            if (rep == 0 && layer == 2) FILLER(S.nwg, 62, 66);
            if (rep == 0 && layer == 3) FILLER(S.nwg, 70, 74);
        }
        SEAM; }
        for (int rep = 0; rep < REP_SCAN; ++rep) { if (rep) ph -= 3;
        if (IN_PH) {
            PH_LOCALS
            for (int unit = bx; unit < 256; unit += G) scan::scan_pair<false>(unit, layer, lds, wave, lane);
        }
        SEAM;
        if (IN_PH) {
            PH_LOCALS
            const float* Db = WSP(float, WS_XG + scan::D_OFF);
            for (int gt = bx * 512 + tid; gt < 32768 + 65536; gt += G * 512) {
                const bool hg = gt >= 32768; const int r = hg ? gt - 32768 : gt, ndt = hg ? 8 : 4, ln = r & 63; int x = r >> 6; const int dt = x % ndt; x /= ndt; const int w = x & 7; x >>= 3; const int dir = x & 1, seq = x >> 1;
                f32x4* E = hg ? WSP(f32x4, WS_XG + scan::E_H_OFF) : WSP(f32x4, WS_XG + scan::E_G_OFF);
                f32x4 carry = (f32x4){0.f, 0.f, 0.f, 0.f};
                for (int i0 = 0; i0 < 32; i0 += 8) {
                    f32x4 e8[8], d8[8];
#pragma unroll
                    for (int j = 0; j < 8; ++j) { const int seg = dir ? 31 - (i0 + j) : (i0 + j); e8[j] = scan::unpack4(((const v2u*)E)[scan::e_index(seq * 32 + seg, dir, w, ndt, dt, ln)]); d8[j] = *(const f32x4*)(Db + scan::d_index(hg ? 1 : 0, seq, dir, seg, 16 * dt + 4 * (ln >> 4))); }
#pragma unroll
                    for (int j = 0; j < 8; ++j) { const int seg = dir ? 31 - (i0 + j) : (i0 + j); ((v2u*)E)[scan::e_index(seq * 32 + seg, dir, w, ndt, dt, ln)] = scan::pack4(carry[0], carry[1], carry[2], carry[3]); carry = d8[j] * carry + e8[j]; }
                }
            }
        }
        SEAM;
        if (IN_PH) {
            PH_LOCALS
            for (int unit = bx; unit < 256; unit += G) {
                scan::scan_unit<64, false, true>(WSP(bf16, WS_BIG), WSP(float, WS_YS), WSP(f32x4, WS_XG + scan::E_G_OFF), nullptr, WSP(bf16, WS_Y), A->in[I_GON] + layer * 128, unit, lds, wave, lane);
                scan::scan_unit<128, true, true>(WSP(bf16, WS_BIG), WSP(float, WS_YS), WSP(f32x4, WS_XG + scan::E_H_OFF), nullptr, WSP(bf16, WS_Y), A->in[I_HON] + layer * 128, unit, lds, wave, lane);
            }
        }
        SEAM; }
        if (IN_PH) {
            PH_LOCALS
            pg8::Gemm g{WSP(bf16, WS_Y), WSP(bf16, WS_WOUT) + (size_t)layer * D * D, D}; pg8::StaticOrder S; S.init(M, D, G, bx);
            EpiRes<0> E{WSP(bf16, WS_HBX), WSP(bf16, WS_HB), SSP(layer * 3 + 1), nullptr, nullptr, ((layer & 1) || F8_DENSE) ? WSP(unsigned char, WS_HQ) : nullptr, 1.0f};
            pg8::gemm_phase<EpiRes<0>, pg8::StaticOrder, true, true>(lds + RING_OFF, g, S, E, wave);
        }
        SEAM;
        if ((layer & 1) == 0) {
            for (int rep = 0; rep < REP_G3; ++rep) { if (rep) --ph;
            if (IN_PH) {
                PH_LOCALS
                #if F8_DENSE
                pg8::Gemm g{WSP(bf16, WS_HQ), (bf16*)(WSP(unsigned char, WS_WGU) + (size_t)(layer >> 1) * 2 * FFD * D), D / 2}; pg8::StaticOrder S; S.init(M, 2 * FFD, G, bx);
                fill_rs_table((LAS float*)(lds + RSTAB_OFF), S, SSP(layer * 3 + 1), nullptr, 1.0f / F8_GMUL, tid);
                EpiSwiGLU<true> E{WSP(bf16, WS_BIG), FFD, (const LAS float*)(lds + RSTAB_OFF)};
                pg8::gemm_phase<EpiSwiGLU<true>, pg8::StaticOrder, true, true, false, true>(lds + RING_OFF, g, S, E, wave);
#else
                pg8::Gemm g{WSP(bf16, WS_HB), WSP(bf16, WS_WGU) + (size_t)(layer >> 1) * 2 * FFD * D, D}; pg8::StaticOrder S; S.init(M, 2 * FFD, G, bx);
                fill_rs_table((LAS float*)(lds + RSTAB_OFF), S, SSP(layer * 3 + 1), nullptr, 1.0f, tid);
                EpiSwiGLU<(F8_DDN != 0)> E{WSP(bf16, WS_BIG), FFD, (const LAS float*)(lds + RSTAB_OFF)};
                pg8::gemm_phase<EpiSwiGLU<(F8_DDN != 0)>, pg8::StaticOrder, true, true>(lds + RING_OFF, g, S, E, wave);
#endif
                if (rep == 0 && layer == 0) FILLER(S.nwg, 40, 45);
                if (rep == 0 && layer >= 2) { PP_TAIL(S.nwg); FILLER(S.nwg, 66, 70); }
            }
            SEAM; }
            if (IN_PH) {
                PH_LOCALS
                #if F8_DENSE || F8_DDN
                pg8::Gemm g{WSP(bf16, WS_BIG), (bf16*)(WSP(unsigned char, WS_WDN) + (size_t)(layer >> 1) * D * FFD), FFD / 2}; pg8::StaticOrder S; S.init(M, D, G, bx);
                EpiRes<0> E{WSP(bf16, WS_HB), WSP(bf16, WS_HB), SSP(layer * 3 + 2), nullptr, nullptr, nullptr, 1.0f / (F8_WMUL * F8_AMUL)};
                pg8::gemm_phase<EpiRes<0>, pg8::StaticOrder, true, true, false, true>(lds + RING_OFF, g, S, E, wave);
#else
                pg8::Gemm g{WSP(bf16, WS_BIG), WSP(bf16, WS_WDN) + (size_t)(layer >> 1) * D * FFD, FFD}; pg8::StaticOrder S; S.init(M, D, G, bx);
                EpiRes<0> E{WSP(bf16, WS_HB), WSP(bf16, WS_HB), SSP(layer * 3 + 2), nullptr, nullptr, nullptr, 1.0f};
                pg8::gemm_phase<EpiRes<0>, pg8::StaticOrder, true, true>(lds + RING_OFF, g, S, E, wave);
#endif
            }
            SEAM;
            ph += 2;
        } else {
            if (IN_PH) {
                PH_LOCALS
                const bf16* hb = WSP(bf16, WS_HB); unsigned* cnt = WSP(unsigned, WS_CTL) + CW_CNT + (layer >> 1) * 8 * 64;
                int* ltok = WSP(int, WS_TAB + TAB_LTOK); float* lw = WSP(float, WS_TAB + TAB_LW); float* rstd_tok = WSP(float, WS_TAB + TAB_RSTD);
                LAS float* wrs = (LAS float*)lds;
                const float* wrt = A->in[I_WR] + (size_t)(layer >> 1) * D * NEXP; const float* nf = A->in[I_NFFN] + layer * D;
                for (int idx = tid; idx < D * NEXP; idx += 512) wrs[idx] = wrt[idx] * nf[idx >> 3];
                __syncthreads();
                for (int m0 = gw; m0 < M; m0 += 2 * NGW) {
                    f32x4 v[2][4]; float rs2[2]; float lg[2][8];
#pragma unroll
                    for (int t = 0; t < 2; ++t) { const int m = (m0 + t * NGW < M) ? m0 + t * NGW : m0; const char* hr = (const char*)hb + ((unsigned)m * (unsigned)(D * 2) + (unsigned)lane * 8u);
#pragma unroll
                        for (int q = 0; q < 4; ++q) { const v2u hw = *(const v2u*)(hr + 512 * q); v[t][q] = (f32x4){bflo(hw.x), bfhi(hw.x), bflo(hw.y), bfhi(hw.y)}; } }
#pragma unroll
                    for (int t = 0; t < 2; ++t) { float s = 0.f;
#pragma unroll
                        for (int q = 0; q < 4; ++q) s += (v[t][q][0] * v[t][q][0] + v[t][q][1] * v[t][q][1]) + (v[t][q][2] * v[t][q][2] + v[t][q][3] * v[t][q][3]);
                        rs2[t] = rsqrtf(wave_sum(s, lane) * (1.0f / 1024.0f) + EPS);
#pragma unroll
                        for (int e = 0; e < 8; ++e) lg[t][e] = 0.f; }
#pragma unroll
                    for (int q = 0; q < 4; ++q)
#pragma unroll
                        for (int c = 0; c < 4; ++c) { const int k = 256 * q + 4 * lane + c; const f32x4 w0 = *(const LAS f32x4*)(wrs + k * 8), w1 = *(const LAS f32x4*)(wrs + k * 8 + 4);
#pragma unroll
                            for (int t = 0; t < 2; ++t) { const float x = v[t][q][c];
                                lg[t][0] += x * w0[0]; lg[t][1] += x * w0[1]; lg[t][2] += x * w0[2]; lg[t][3] += x * w0[3]; lg[t][4] += x * w1[0]; lg[t][5] += x * w1[1]; lg[t][6] += x * w1[2]; lg[t][7] += x * w1[3]; } }
                    int i1[2], i2[2]; float p1[2], p2[2];
#pragma unroll
                    for (int t = 0; t < 2; ++t) { float mx = -1e30f;
#pragma unroll
                        for (int e = 0; e < 8; ++e) { lg[t][e] = wave_sum(lg[t][e], lane) * rs2[t]; mx = fmaxf(mx, lg[t][e]); }
                        float pe[8];
#pragma unroll
                        for (int e = 0; e < 8; ++e) pe[e] = __expf(lg[t][e] - mx);
                        i1[t] = 0; p1[t] = pe[0];
#pragma unroll
                        for (int e = 1; e < 8; ++e) if (pe[e] > p1[t]) { p1[t] = pe[e]; i1[t] = e; }
                        i2[t] = 0; p2[t] = -1.f;
#pragma unroll
                        for (int e = 0; e < 8; ++e) if (e != i1[t] && pe[e] > p2[t]) { p2[t] = pe[e]; i2[t] = e; } }
                    if (lane == 0) { unsigned qa[2] = {0u, 0u}, qb[2] = {0u, 0u};
#pragma unroll
                        for (int t = 0; t < 2; ++t) if (m0 + t * NGW < M) { qa[t] = __hip_atomic_fetch_add(cnt + 64 * i1[t], 1u, RLX_AGENT); qb[t] = __hip_atomic_fetch_add(cnt + 64 * i2[t], 1u, RLX_AGENT); }
#pragma unroll
                        for (int t = 0; t < 2; ++t) if (m0 + t * NGW < M) { const int m = m0 + t * NGW; const float w1 = p1[t] / (p1[t] + p2[t]), w2 = p2[t] / (p1[t] + p2[t]);
                            ltok[i1[t] * M + qa[t]] = m; lw[i1[t] * M + qa[t]] = w1; ltok[i2[t] * M + qb[t]] = m | (1 << 16); lw[i2[t] * M + qb[t]] = w2; rstd_tok[m] = rs2[t]; } }
                }
            }
            SEAM;
            for (int rep = 0; rep < REP_G5; ++rep) { if (rep) --ph;
            if (IN_PH) {
                PH_LOCALS
                #if F8_EGU
                pg8::Gemm g{WSP(bf16, WS_HQ), (bf16*)(WSP(unsigned char, WS_WEGU) + (size_t)(layer >> 1) * 8 * 2 * FFE * D), D / 2, WSP(int, WS_TAB + TAB_LTOK)};
#else
                pg8::Gemm g{WSP(bf16, WS_HB), WSP(bf16, WS_WEGU) + (size_t)(layer >> 1) * 8 * 2 * FFE * D, D, WSP(int, WS_TAB + TAB_LTOK)};
#endif
                pg8::GroupedOrder S; S.init(WSP(unsigned, WS_CTL) + CW_CNT + (layer >> 1) * 8 * 64, 2 * FFE / 256, G, bx, M);
                #if F8_EGU
                fill_rs_table((LAS float*)(lds + RSTAB_OFF), S, nullptr, WSP(float, WS_TAB + TAB_RSTD), 1.0f / F8_GMUL, tid, WSP(int, WS_TAB + TAB_LTOK));
                EpiSwiGLU<true> E{WSP(bf16, WS_BIG), FFE, (const LAS float*)(lds + RSTAB_OFF)};
                pg8::gemm_phase<EpiSwiGLU<true>, pg8::GroupedOrder, true, true, true, true>(lds + RING_OFF, g, S, E, wave);
#else
                fill_rs_table((LAS float*)(lds + RSTAB_OFF), S, nullptr, WSP(float, WS_TAB + TAB_RSTD), 1.0f, tid, WSP(int, WS_TAB + TAB_LTOK));
                EpiSwiGLU<true> E{WSP(bf16, WS_BIG), FFE, (const LAS float*)(lds + RSTAB_OFF)};
                pg8::gemm_phase<EpiSwiGLU<true>, pg8::GroupedOrder, true, true, true, false>(lds + RING_OFF, g, S, E, wave);
#endif
                if (rep == 0 && layer == 1) { FILLER(S.U, 10, 20); FILLER(S.U, 23, 26); }
                if (rep == 0 && layer >= 2) PP_TAIL(S.U);
            }
            SEAM; }
            if (IN_PH) {
                PH_LOCALS
                pg8::Gemm g{WSP(bf16, WS_BIG), (bf16*)(WSP(unsigned char, WS_WEDN) + (size_t)(layer >> 1) * 8 * D * FFE), FFE / 2}; pg8::GroupedOrder S; S.init(WSP(unsigned, WS_CTL) + CW_CNT + (layer >> 1) * 8 * 64, D / 256, G, bx, M);
                EpiScatter E{WSP(bf16, WS_YS), WSP(int, WS_TAB + TAB_LTOK), WSP(float, WS_TAB + TAB_LW)};
                pg8::gemm_phase<EpiScatter, pg8::GroupedOrder, true, true, false, true>(lds + RING_OFF, g, S, E, wave);
                if (layer == 1) FILLER(S.U, ND_PRO, 62);
            }
            SEAM;
            if (IN_PH) {
                PH_LOCALS
                const bf16* YS = WSP(bf16, WS_YS); bf16* HB = WSP(bf16, WS_HB); float* ss_ple = SSP(layer * 3 + 2);
                const char* Y0c = (const char*)YS; const char* Y1c = (const char*)(YS + (size_t)M * D); char* HBc = (char*)HB;
                for (int m0 = gw; m0 < M; m0 += 2 * NGW) { v2u hv[2][4], av[2][4], bv[2][4];
#pragma unroll
                    for (int r = 0; r < 2; ++r) { const int m = m0 + r * NGW < M ? m0 + r * NGW : m0; const unsigned ob = (unsigned)m * (unsigned)(D * 2) + (unsigned)lane * 8u;
#pragma unroll
                        for (int q = 0; q < 4; ++q) { hv[r][q] = *(const v2u*)(HBc + (ob + 512u * q)); av[r][q] = *(const v2u*)(Y0c + (ob + 512u * q)); bv[r][q] = *(const v2u*)(Y1c + (ob + 512u * q)); } }
#pragma unroll
                    for (int r = 0; r < 2; ++r) { const int m = m0 + r * NGW; if (m < M) { const unsigned ob = (unsigned)m * (unsigned)(D * 2) + (unsigned)lane * 8u; float s = 0.f;
#pragma unroll
                        for (int q = 0; q < 4; ++q) { const v2u hw = hv[r][q], a = av[r][q], b = bv[r][q];
                            v2u w; w.x = pg8::cvt_pk_bf16(bflo(hw.x) + (bflo(a.x) + bflo(b.x)), bfhi(hw.x) + (bfhi(a.x) + bfhi(b.x))); w.y = pg8::cvt_pk_bf16(bflo(hw.y) + (bflo(a.y) + bflo(b.y)), bfhi(hw.y) + (bfhi(a.y) + bfhi(b.y)));
                            *(v2u*)(HBc + (ob + 512u * q)) = w; const float r0 = bflo(w.x), r1 = bfhi(w.x), r2 = bflo(w.y), r3 = bfhi(w.y); s += (r0 * r0 + r1 * r1) + (r2 * r2 + r3 * r3); }
                        s = wave_sum(s, lane); if (lane < 16) ss_ple[(size_t)m * 16 + lane] = lane == 0 ? s : 0.f; } } }
            }
            SEAM;
        }
        if (IN_PH) {
            if (layer < 2) { PH_LOCALS
              pg8::Gemm g{WSP(bf16, WS_PB) + (size_t)layer * M * PLE, WSP(bf16, WS_WPP) + (size_t)layer * D * PLE, PLE}; pg8::StaticOrder S; S.init(M, D, G, bx);
              EpiBf16Plain E{WSP(bf16, WS_PP)};
              pg8::gemm_phase<EpiBf16Plain, pg8::StaticOrder, true, true>(lds + RING_OFF, g, S, E, wave); }
            VM_WAIT(); __syncthreads();
            { PH_LOCALS
              pg8::Gemm g{WSP(bf16, WS_HB), WSP(bf16, WS_WPG) + (size_t)layer * D * D, D}; pg8::StaticOrder S; S.init(M, D, G, bx);
              EpiRes<1> E{WSP(bf16, WS_HB), WSP(bf16, WS_HBX), SSP(layer * 3 + 3), SSP(layer * 3 + 2), WSP(bf16, WS_PP), nullptr, 1.0f};
              pg8::gemm_phase<EpiRes<1>, pg8::StaticOrder, true, true>(lds + RING_OFF, g, S, E, wave); }
        }
        SEAM;
    }
    if (IN_PH) {
        PH_LOCALS
        float* out = A->out; const bf16* hb = WSP(bf16, WS_HBX); const float* ssf = SSP(12); const f32x4* nw = (const f32x4*)A->in[I_NFIN] + lane;
        f32x4 wn[4];
#pragma unroll
        for (int q = 0; q < 4; ++q) wn[q] = nw[64 * q];
        for (int m0 = gw; m0 < M; m0 += 4 * NGW) { v2u hv[4][4]; float rs4[4];
#pragma unroll
            for (int r = 0; r < 4; ++r) { const int m = m0 + r * NGW; if (m < M) { const v2u* hr = (const v2u*)(hb + (size_t)m * D) + lane; rs4[r] = ss_load(ssf, m);
#pragma unroll
                for (int q = 0; q < 4; ++q) hv[r][q] = hr[64 * q]; } }
#pragma unroll
            for (int r = 0; r < 4; ++r) { const int m = m0 + r * NGW; if (m < M) { f32x4* orow = (f32x4*)(out + (size_t)m * D) + lane; const float rs = rsqrtf(rs4[r] * (1.0f / 1024.0f) + EPS);
#pragma unroll
                for (int q = 0; q < 4; ++q) { const v2u hw = hv[r][q]; __builtin_nontemporal_store((f32x4){bflo(hw.x), bfhi(hw.x), bflo(hw.y), bfhi(hw.y)} * rs * wn[q], orow + 64 * q); } } } }
    }
#undef IN_PH
#undef SEAM
}
constexpr int PH_PER_LAYER = 10, N_PHASES = 2 + DEPTH * PH_PER_LAYER;

extern "C" void kernel_launch(void* const* d_in, const int* in_sizes, int n_in, void* d_out, int out_size, void* d_ws, size_t ws_size, hipStream_t stream) {
    static int grid = 0;
    if (grid == 0) {
        if (n_in != 22 || out_size != M * D || ws_size < WS_END) { fprintf(stderr, "kernel_launch: unexpected shapes (n_in %d, out %d, ws %zu need %zu); nothing launched\n", n_in, out_size, ws_size, (size_t)WS_END); grid = -1; return; }
        int dev = 0, cus = 0;
        if (hipGetDevice(&dev) != hipSuccess || hipDeviceGetAttribute(&cus, hipDeviceAttributeMultiprocessorCount, dev) != hipSuccess) { grid = -1; return; }
        if (hipFuncSetAttribute((const void*)mk_fwd, hipFuncAttributeMaxDynamicSharedMemorySize, LDS_BYTES) != hipSuccess) { fprintf(stderr, "kernel_launch: hipFuncSetAttribute failed\n"); grid = -1; return; }
        int per_cu = 0;
        if (hipOccupancyMaxActiveBlocksPerMultiprocessor(&per_cu, (const void*)mk_fwd, NWAVES * 64, LDS_BYTES) != hipSuccess || per_cu < 1) fprintf(stderr, "kernel_launch: occupancy query says %d\n", per_cu);
        (void)hipGetLastError();
        grid = cus;
    }
    if (grid < 0) return;
    if (hipMemsetAsync((char*)d_ws + WS_CTL, 0, CTL_ZERO_BYTES, stream) != hipSuccess) return;
    Args a{};
    for (int i = 0; i < 22; ++i) a.in[i] = (const float*)d_in[i];
    a.out = (float*)d_out; a.ws = (unsigned char*)d_ws;
#if MK_MULTI
    for (int k = 0; k < N_PHASES; ++k) {
        if (k >= 1 && k < 1 + DEPTH * PH_PER_LAYER) { const int layer = (k - 1) / PH_PER_LAYER, p = (k - 1) % PH_PER_LAYER; if ((layer & 1) == 0 && p >= 7 && p <= 8) continue; }
        a.ph_lo = k; a.ph_hi = k + 1;
        hipLaunchKernelGGL(mk_fwd, dim3(grid), dim3(NWAVES * 64), LDS_BYTES, stream, a);
    }
#else
    a.ph_lo = 0; a.ph_hi = N_PHASES; a.flags = MK_FLAGS; a.pad_ = 0;
    hipLaunchKernelGGL(mk_fwd, dim3(grid), dim3(NWAVES * 64), LDS_BYTES, stream, a);
#endif
    const hipError_t le = hipPeekAtLastError();
    if (le != hipSuccess) fprintf(stderr, "kernel_launch: launch failed: %s\n", hipGetErrorName(le));
}
```

```cpp
#include <hip/hip_runtime.h>
#include <cstdio>
#include <cstdint>

#ifndef REP_PRO
#define REP_PRO 1
#endif
#ifndef REP_G1
#define REP_G1 1
#endif
#ifndef REP_SCAN
#define REP_SCAN 1
#endif
#ifndef REP_G5
#define REP_G5 1
#endif
#ifndef REP_G3
#define REP_G3 1
#endif
#ifndef MK_MULTI
#define MK_MULTI 0
#endif

namespace pg8 {
#define PG8_LAS __attribute__((address_space(3)))
typedef unsigned short bf16_t;
typedef short bf16x8 __attribute__((ext_vector_type(8)));
typedef float f32x4 __attribute__((ext_vector_type(4)));
typedef unsigned u32x4 __attribute__((ext_vector_type(4)));
typedef unsigned u32x2 __attribute__((ext_vector_type(2)));
constexpr int BM = 256, BK = 64, HALF = 128, HTB = HALF * BK * 2, STAGE_BYTES = 8 * HTB, NXCD = 8, WGM = 8;

__host__ __device__ __forceinline__ int lds_byte(int r, int c) { const int st = (r >> 4) * 2 + (c >> 5), rr = r & 15, cc = c & 31, ob = rr * 64 + cc * 2; return st * 1024 + (ob ^ (((ob >> 9) & 1) << 5)); }
__host__ __device__ __forceinline__ void stage_rc(int b, int& R, int& C) { const int st = b / 1024, sb = b % 1024, swz = sb ^ (((sb >> 9) & 1) << 5); R = (st >> 1) * 16 + swz / 64; C = (st & 1) * 32 + (swz % 64) / 2; }
__host__ __device__ __forceinline__ int perm32(int rho) { const int n = rho >> 4, i = rho & 15; return 8 * (i >> 2) + 4 * n + (i & 3); }

struct Unit { int pm, pn, pnl, ord, rbase, nvalid; };
struct Gemm { const bf16_t* A; const bf16_t* Bt; int K; const int* rowsrc; };

template <bool F8> struct FragT { typedef bf16x8 A[4][2]; typedef bf16x8 B[2][2]; };
typedef int v8i_t __attribute__((ext_vector_type(8)));
template <> struct FragT<true> { typedef v8i_t A[4]; typedef v8i_t B[2]; };
typedef int v4i_t __attribute__((ext_vector_type(4)));
__device__ __forceinline__ int xcd_remap(int wgid, int nwg) { const int q = nwg / NXCD, r = nwg % NXCD, xcd = wgid % NXCD, off = wgid / NXCD; return (xcd < r ? xcd * (q + 1) : r * (q + 1) + (xcd - r) * q) + off; }

struct StaticOrder {
    int nM, nN, nwg, G, c;
    __device__ void init(int M, int N, int G_, int c_) { nM = M / BM; nN = N / BM; nwg = nM * nN; G = G_; c = c_; }
    __device__ bool next(int i, Unit& u) const {
        const long L = (long)i * G + c; if (L >= nwg) return false;
        const int wgid = xcd_remap((int)L, nwg);
        const int nig = WGM * nN, gid = wgid / nig, fm = gid * WGM, gsz = (nM - fm) < WGM ? (nM - fm) : WGM;
        u.pm = fm + ((wgid % nig) % gsz); u.pn = (wgid % nig) / gsz; u.pnl = u.pn; u.ord = i; u.rbase = 0; u.nvalid = 256; return true;
    }
    __device__ __forceinline__ void a_ready(const Unit&) const {}
    __device__ __forceinline__ void done(const Unit&) const {}
};
struct GroupedOrder {
    unsigned cn[8], cr[8]; int nN, U, G, c, ldl;
    __device__ void init(const unsigned* cnt64, int nN_, int G_, int c_, int ldl_ = 0) {
        int t = 0;
#pragma unroll
        for (int e = 0; e < 8; ++e) { cr[e] = __hip_atomic_load(cnt64 + 64 * e, __ATOMIC_RELAXED, __HIP_MEMORY_SCOPE_AGENT); cn[e] = (cr[e] + 255u) >> 8; t += (int)cn[e]; }
        nN = nN_; U = t * nN; G = G_; c = c_; ldl = ldl_;
    }
    __device__ bool next(int i, Unit& u) const {
        const long L = (long)i * G + c; if (L >= U) return false;
        const int w0 = xcd_remap((int)L, U);
        int base = 0, tb = 0, es = 0, bs = 0, ns = 1, ts = 0, rw = 0;
#pragma unroll
        for (int e = 0; e < 8; ++e) { const int n = (int)cn[e], ue = n * nN; const bool hit = (w0 >= base) && (w0 < base + ue); if (hit) { es = e; bs = base; ns = n; ts = tb; rw = (int)cr[e]; } base += ue; tb += n; }
        const int w = w0 - bs, nig = WGM * nN, gid = w / nig, fm = gid * WGM, gsz = (ns - fm) < WGM ? (ns - fm) : WGM;
        const int tl = fm + ((w % nig) % gsz);
        u.pm = ts + tl; u.pnl = (w % nig) / gsz; u.pn = es * nN + u.pnl; u.ord = i; u.rbase = es * ldl + tl * 256; u.nvalid = (rw - tl * 256) < 256 ? (rw - tl * 256) : 256; return true;
    }
    __device__ __forceinline__ void a_ready(const Unit&) const {}
    __device__ __forceinline__ void done(const Unit&) const {}
};

typedef float f32x2_t __attribute__((ext_vector_type(2)));
typedef __bf16 bf16x2_t __attribute__((ext_vector_type(2)));
__device__ __forceinline__ unsigned cvt_pk_bf16(float lo, float hi) { const f32x2_t v = {lo, hi}; const bf16x2_t b = __builtin_convertvector(v, bf16x2_t); return __builtin_bit_cast(unsigned, b); }

template <class Epi, class Sched, bool ALIGN_EPI = false, bool SP2 = false, bool GATHER = false, bool FP8 = false>
__device__ __forceinline__ void gemm_phase(PG8_LAS unsigned char* lds, const Gemm g, const Sched& S, const Epi& E, int wid_s) {
    int lane_; asm volatile("v_mbcnt_lo_u32_b32 %0, -1, 0\n\tv_mbcnt_hi_u32_b32 %0, -1, %0" : "=v"(lane_));
    const int wid = wid_s, lane = lane_, tid = wid * 64 + lane, wr = wid >> 2, wc = wid & 3, fr = lane & 15, fq = lane >> 4;
    const int K = g.K, nt = K / BK;
    unsigned voffA[2], voffB[2]; int gR[2]; unsigned gC[2];
#pragma unroll
    for (int i = 0; i < 2; ++i) { int R, C; stage_rc(tid * 16 + i * 8192, R, C); const int Rb = Epi::PERM ? ((R & ~31) + perm32(R & 31)) : R;
        voffA[i] = (unsigned)(R * K + C) * 2u; voffB[i] = (unsigned)(Rb * K + C) * 2u; gR[i] = R; gC[i] = (unsigned)C * 2u; }
    unsigned gvc[2][2], gvn[2][2];
#define PG8_GOFF(dst, un) do { if constexpr (GATHER) { _Pragma("unroll") for (int h_ = 0; h_ < 2; ++h_) _Pragma("unroll") for (int i_ = 0; i_ < 2; ++i_) \
        { const int r_ = h_ * HALF + gR[i_]; dst[h_][i_] = (unsigned)(g.rowsrc[(un).rbase + (r_ < (un).nvalid ? r_ : (un).nvalid - 1)] & 0xffff) * (unsigned)(K * 2) + gC[i_]; } } } while (0)
#define PG8_STAGE_A(bufoff, nextu, h, kbyte) do { if constexpr (GATHER) { _Pragma("unroll") for (int _i = 0; _i < 2; ++_i) \
        __builtin_amdgcn_global_load_lds((const unsigned*)((const char*)g.A + (size_t)(kbyte) + ((nextu) ? gvn[h][_i] : gvc[h][_i])), (PG8_LAS unsigned*)(lds + (bufoff) + ldsw + _i * 8192), 16, 0, 0); } \
        else { PG8_STAGE(bufoff, ((nextu) ? nA : cA) + (size_t)(h) * hstep + (size_t)(kbyte), voffA); } } while (0)
    const size_t kstep = (size_t)(BK * 2);
    const size_t hstep = (size_t)HALF * K * 2;
    const size_t tstep = 2 * hstep;
    const unsigned ldsw = (unsigned)wid * 1024u;
    const int aoff = FP8 ? lds_byte(wr * 64 + fr, fq * 16) : lds_byte(wr * 64 + fr, fq * 8), boff = FP8 ? lds_byte(wc * 32 + fr, fq * 16) : lds_byte(wc * 32 + fr, fq * 8);
#define PG8_SA(b, h) (((b) * 2 + (h)) * HTB)
#define PG8_SB(b, h) ((4 + (b) * 2 + (h)) * HTB)
#define PG8_STAGE(bufoff, gbase, voff) do { _Pragma("unroll") for (int _i = 0; _i < 2; ++_i) \
        __builtin_amdgcn_global_load_lds((const unsigned*)((const char*)(gbase) + (voff)[_i]), (PG8_LAS unsigned*)(lds + (bufoff) + ldsw + _i * 8192), 16, 0, 0); } while (0)
#define PG8_LDA(dst, b, h) do { if constexpr (FP8) { _Pragma("unroll") for (int m = 0; m < 4; ++m) { const PG8_LAS v4i_t* p_ = (const PG8_LAS v4i_t*)(lds + PG8_SA(b, h) + aoff + m * 2048); dst[m] = __builtin_shufflevector(p_[0], p_[1], 0, 1, 2, 3, 4, 5, 6, 7); } } \
        else { _Pragma("unroll") for (int m = 0; m < 4; ++m) _Pragma("unroll") for (int k = 0; k < 2; ++k) dst[m][k] = *(const PG8_LAS bf16x8*)(lds + PG8_SA(b, h) + aoff + m * 2048 + k * 1024); } } while (0)
#define PG8_LDB(dst, b, h) do { if constexpr (FP8) { _Pragma("unroll") for (int n = 0; n < 2; ++n) { const PG8_LAS v4i_t* p_ = (const PG8_LAS v4i_t*)(lds + PG8_SB(b, h) + boff + n * 2048); dst[n] = __builtin_shufflevector(p_[0], p_[1], 0, 1, 2, 3, 4, 5, 6, 7); } } \
        else { _Pragma("unroll") for (int n = 0; n < 2; ++n) _Pragma("unroll") for (int k = 0; k < 2; ++k) dst[n][k] = *(const PG8_LAS bf16x8*)(lds + PG8_SB(b, h) + boff + n * 2048 + k * 1024); } } while (0)
#define PG8_MMA(ai, bj, At, Bt) do { __builtin_amdgcn_s_setprio(1); _Pragma("unroll") for (int m = 0; m < 4; ++m) _Pragma("unroll") for (int n = 0; n < 2; ++n) { \
        if constexpr (FP8) asm volatile("v_mfma_scale_f32_16x16x128_f8f6f4 %0, %1, %2, %0, %3, %3 op_sel_hi:[0,0,0]" : "+v"(acc[ai][bj][m][n]) : "v"(Bt[n]), "v"(At[m]), "v"(one8));   \
        else { _Pragma("unroll") for (int k = 0; k < 2; ++k) acc[ai][bj][m][n] = __builtin_amdgcn_mfma_f32_16x16x32_bf16(Bt[n][k], At[m][k], acc[ai][bj][m][n], 0, 0, 0); } } __builtin_amdgcn_s_setprio(0); } while (0)
#define PG8_WAIT_V(n) asm volatile("s_waitcnt vmcnt(" #n ")" ::: "memory")
#define PG8_WAIT_L(n) asm volatile("s_waitcnt lgkmcnt(" #n ")" ::: "memory")
#define PG8_WVS_(NSTR, f_) asm volatile("s_cmp_lg_u32 %0, 0\n\ts_cbranch_scc1 1f\n\ts_waitcnt vmcnt(8)\n\ts_branch 2f\n1:\n\ts_waitcnt vmcnt(" NSTR ")\n2:" : : "s"(f_) : "scc", "memory")
#define PG8_WAIT_VS(flag) do { constexpr int n_ = 8 + Epi::NSTORE + (GATHER ? 4 : 0); const int f_ = __builtin_amdgcn_readfirstlane(flag); static_assert(n_ == 12 || n_ == 16 || n_ == 20 || n_ == 24 || n_ == 28, "relaxed wait count"); \
        if constexpr (n_ == 12) PG8_WVS_("12", f_); else if constexpr (n_ == 16) PG8_WVS_("16", f_); else if constexpr (n_ == 20) PG8_WVS_("20", f_); else if constexpr (n_ == 24) PG8_WVS_("24", f_); else PG8_WVS_("28", f_); } while (0)
#define PG8_BAR __builtin_amdgcn_s_barrier()
#define PG8_SCHED __builtin_amdgcn_sched_barrier(0)
    Unit cur, nxt; int ui = 0;
    if (!S.next(0, cur)) return;
    f32x4 acc[2][2][4][2];
#pragma unroll
    for (int a = 0; a < 2; ++a)
#pragma unroll
        for (int b = 0; b < 2; ++b)
#pragma unroll
            for (int m = 0; m < 4; ++m)
#pragma unroll
                for (int n = 0; n < 2; ++n) acc[a][b][m][n] = (f32x4){0.f, 0.f, 0.f, 0.f};
    typename FragT<FP8>::A At; typename FragT<FP8>::B B0, B1; int one8 = 0x7f7f7f7f; if constexpr (FP8) asm volatile("" : "+v"(one8)); (void)one8;
    const char* cA = (const char*)g.A + (size_t)cur.pm * tstep; const char* cB = (const char*)g.Bt + (size_t)cur.pn * tstep;
    S.a_ready(cur);
    PG8_GOFF(gvc, cur);
    if constexpr (SP2) {
        const char* nA = cA;
        PG8_STAGE(PG8_SB(0, 0), cB, voffB); PG8_STAGE(PG8_SB(0, 1), cB + hstep, voffB); PG8_STAGE_A(PG8_SA(0, 0), false, 0, 0); PG8_STAGE_A(PG8_SA(0, 1), false, 1, 0);
        if (wr == 1) PG8_BAR;
        PG8_WAIT_V(2); PG8_BAR;
        PG8_STAGE(PG8_SB(1, 0), cB + kstep, voffB); PG8_STAGE_A(PG8_SA(1, 0), false, 0, kstep); PG8_STAGE(PG8_SB(1, 1), cB + hstep + kstep, voffB);
        PG8_WAIT_V(6); PG8_BAR;
    } else {
        PG8_STAGE(PG8_SB(0, 0), cB, voffB); PG8_STAGE(PG8_SA(0, 0), cA, voffA); PG8_STAGE(PG8_SB(0, 1), cB + hstep, voffB); PG8_STAGE(PG8_SA(0, 1), cA + hstep, voffA);
        if (wr == 1) PG8_BAR;
        PG8_WAIT_V(4); PG8_BAR;
        PG8_STAGE(PG8_SB(1, 0), cB + kstep, voffB); PG8_STAGE(PG8_SA(1, 0), cA + kstep, voffA); PG8_STAGE(PG8_SB(1, 1), cB + hstep + kstep, voffB);
        PG8_WAIT_V(6); PG8_BAR;
    }
    for (;;) {
        const bool has_next = S.next(ui + 1, nxt);
        const char* nA = has_next ? (const char*)g.A + (size_t)nxt.pm * tstep : cA; const char* nB = has_next ? (const char*)g.Bt + (size_t)nxt.pn * tstep : cB;
        { const Unit& gu_ = has_next ? nxt : cur; PG8_GOFF(gvn, gu_); }
#define PG8_TRIP(W1, W2) do { \
            const bool last = (t == nt - 2); \
            const char* b2 = last ? nB : cB + (size_t)(t + 2) * kstep; const char* b3 = b2 + kstep; \
            if (last && has_next) S.a_ready(nxt); \
            const size_t k1b = (size_t)(t + 1) * kstep, k2b = last ? (size_t)0 : (size_t)(t + 2) * kstep, k3b = k2b + kstep; \
            PG8_LDB(B0, 0, 0); PG8_LDB(B1, 0, 1); PG8_SCHED; PG8_LDA(At, 0, 0); PG8_STAGE_A(PG8_SA(1, 1), false, 1, k1b); \
            W1; PG8_WAIT_L(0); PG8_BAR; PG8_MMA(0, 0, At, B0); PG8_MMA(0, 1, At, B1); PG8_BAR; PG8_SCHED; \
            PG8_LDA(At, 0, 1); PG8_STAGE(PG8_SB(0, 0), b2, voffB); PG8_STAGE(PG8_SB(0, 1), b2 + hstep, voffB); PG8_STAGE_A(PG8_SA(0, 0), last, 0, k2b); \
            W2; PG8_WAIT_L(0); PG8_BAR; PG8_MMA(1, 0, At, B0); PG8_MMA(1, 1, At, B1); PG8_BAR; PG8_SCHED; \
            PG8_LDB(B0, 1, 0); PG8_LDB(B1, 1, 1); PG8_SCHED; PG8_LDA(At, 1, 0); PG8_STAGE_A(PG8_SA(0, 1), last, 1, k2b); \
            PG8_WAIT_V(8); PG8_WAIT_L(0); PG8_BAR; PG8_MMA(0, 0, At, B0); PG8_MMA(0, 1, At, B1); PG8_BAR; PG8_SCHED; \
            PG8_LDA(At, 1, 1); PG8_STAGE(PG8_SB(1, 0), b3, voffB); PG8_STAGE(PG8_SB(1, 1), b3 + hstep, voffB); PG8_STAGE_A(PG8_SA(1, 0), last, 0, k3b); \
            PG8_WAIT_V(8); PG8_WAIT_L(0); PG8_BAR; PG8_MMA(1, 0, At, B0); PG8_MMA(1, 1, At, B1); PG8_BAR; PG8_SCHED; } while (0)
        static_assert(SP2, "only the two-super-phase loop is kept");
        for (int t = 0; t < nt; t += 2) {
            if constexpr (Epi::NSTORE > 0) { const int rlx = (ui > 0 && t == 0) ? 1 : 0;
                PG8_TRIP(PG8_WAIT_VS(rlx), PG8_WAIT_VS(rlx)); }
            else PG8_TRIP(PG8_WAIT_V(8), PG8_WAIT_V(8));
        }
#undef PG8_TRIP
        if constexpr (ALIGN_EPI) { if (wr == 0) PG8_BAR; }
        E(acc, cur, wr, wc); S.done(cur);
        if (!has_next) break;
#pragma unroll
        for (int a = 0; a < 2; ++a)
#pragma unroll
            for (int b = 0; b < 2; ++b)
#pragma unroll
                for (int m = 0; m < 4; ++m)
#pragma unroll
                    for (int n = 0; n < 2; ++n) acc[a][b][m][n] = (f32x4){0.f, 0.f, 0.f, 0.f};
        cur = nxt; cA = nA; cB = nB; ++ui;
        if constexpr (GATHER) { _Pragma("unroll") for (int h_ = 0; h_ < 2; ++h_) _Pragma("unroll") for (int i_ = 0; i_ < 2; ++i_) gvc[h_][i_] = gvn[h_][i_]; }
        if constexpr (ALIGN_EPI) { if (wr == 1) PG8_BAR; }
    }
    PG8_WAIT_V(0);
    if constexpr (!ALIGN_EPI) { if (wr == 0) PG8_BAR; }
    PG8_BAR;
#undef PG8_GOFF
#undef PG8_STAGE_A
#undef PG8_SA
#undef PG8_SB
#undef PG8_STAGE
#undef PG8_LDA
#undef PG8_LDB
#undef PG8_MMA
#undef PG8_WAIT_V
#undef PG8_WAIT_L
#undef PG8_WAIT_VS
#undef PG8_WVS_
#undef PG8_BAR
#undef PG8_SCHED
}
}

constexpr int BATCH = 2, SEQ = 8192, D = 1024, DEPTH = 4, M = BATCH * SEQ;
constexpr int DIN = 4128, NPROJ = 4608, FFD = 2816, FFE = 3584, NEXP = 8, PLE = 256;
constexpr float EPS = 1e-6f, HEAD_EPS = 1e-5f, F_MIN = 1e-6f;
#ifndef F8_DENSE
#define F8_DENSE 0
#endif
#ifndef F8_DDN
#define F8_DDN 1
#endif
#ifndef F8_EGU
#define F8_EGU 1
#endif
constexpr float F8_WMUL = 32.0f, F8_AMUL = 4.0f, F8_GMUL = 16.0f;
constexpr int PC_GQ = 0, PC_GK = 256, PC_GV = 512, PC_GR = 1024, PC_HQ = 1536, PC_HFF = 2048, PC_HFB = 2560, PC_HV = 3072, PC_HR = 3584, PC_GGF = 4096, PC_GGB = 4352;
__host__ __device__ constexpr unsigned pofs(int tok, int col) { return (unsigned)(((col >> 8) * (2 * 8192) + tok) * 256 + (col & 255)); }
constexpr int XG_ROWS = 34816;

constexpr size_t MiB = 1u << 20;
constexpr size_t WS_CTL = 0, CTL_ZERO_BYTES = 1 * MiB;
constexpr size_t WS_TAB = 2 * MiB;
constexpr size_t TAB_LB = 0, TAB_LTOK = 64 * 1024, TAB_LW = TAB_LTOK + 512 * 1024, TAB_RSTD = TAB_LW + 512 * 1024, TAB_RINFO = TAB_RSTD + 64 * 1024, TAB_RRSTD = TAB_RINFO + 512 * 1024, TAB_ROWTOK = TAB_RRSTD + 256 * 1024;
constexpr size_t WS_WIN = 8 * MiB;
constexpr size_t WS_WOUT = WS_WIN + 36 * MiB;
constexpr size_t WS_WGU = WS_WOUT + 8 * MiB;
constexpr size_t WS_WDN = WS_WGU + 22 * MiB;
constexpr size_t WS_WEGU = WS_WDN + 11 * MiB;
constexpr size_t WS_WEDN = WS_WEGU + 224 * MiB;
constexpr size_t WS_WPG = WS_WEDN + 112 * MiB;
constexpr size_t WS_WPP = WS_WPG + 8 * MiB;
constexpr size_t WS_HB = WS_WPP + 2 * MiB;
constexpr size_t WS_PB = WS_HB + 32 * MiB;
constexpr size_t WS_Y = WS_PB + 32 * MiB;
constexpr size_t WS_PP = WS_Y + 32 * MiB;
constexpr size_t WS_YS = WS_PP + 32 * MiB;
constexpr size_t WS_XG = WS_YS + 64 * MiB;
constexpr size_t WS_HQ = WS_XG;
constexpr size_t WS_BIG = WS_XG + 68 * MiB;
constexpr size_t WS_HBX = WS_BIG + 238 * MiB;
constexpr size_t WS_END = WS_HBX + 32 * MiB;
constexpr int CW_TMO = 0, CW_BAR = 4096, CW_CNT = 8192, CW_SS = 16384;
static_assert((CW_SS + 13 * M) * 4 <= (int)CTL_ZERO_BYTES, "ctl");

constexpr int NWAVES = 8;
constexpr int RING_OFF = 0, RING_BYTES = 131072;
constexpr int LDSCTL_OFF = RING_BYTES, MISC_OFF = LDSCTL_OFF + 320;
constexpr int LDS_BYTES = 147456;
constexpr int RSTAB_OFF = MISC_OFF + 128, RSTAB_UNITS = 15;
static_assert(RSTAB_OFF % 16 == 0 && RSTAB_OFF + RSTAB_UNITS * 1024 <= LDS_BYTES, "rs table");

#define GAS __attribute__((address_space(1)))
#define LAS __attribute__((address_space(3)))
typedef unsigned short bf16;
typedef unsigned v4u __attribute__((ext_vector_type(4)));
typedef unsigned v2u __attribute__((ext_vector_type(2)));
typedef float f32x4 __attribute__((ext_vector_type(4)));
typedef GAS unsigned gu32;
#define RLX_AGENT __ATOMIC_RELAXED, __HIP_MEMORY_SCOPE_AGENT
#define LDS_WAIT() asm volatile("s_waitcnt lgkmcnt(0)" ::: "memory")
#define VM_WAIT() asm volatile("s_waitcnt vmcnt(0)" ::: "memory")
__device__ __forceinline__ unsigned f2bf(float f) { unsigned u = __builtin_bit_cast(unsigned, f); return (u + 0x7fffu + ((u >> 16) & 1u)) >> 16; }
__device__ __forceinline__ unsigned pk2(float lo, float hi) { return f2bf(lo) | (f2bf(hi) << 16); }
__device__ __forceinline__ float bflo(unsigned w) { return __builtin_bit_cast(float, w << 16); }
__device__ __forceinline__ float bfhi(unsigned w) { return __builtin_bit_cast(float, w & 0xffff0000u); }
__device__ __forceinline__ float bf1(bf16 b) { return __builtin_bit_cast(float, ((unsigned)b) << 16); }
__device__ __forceinline__ float sigm(float x) { return __builtin_amdgcn_rcpf(1.0f + __expf(-x)); }
__device__ __forceinline__ float silu(float x) { return x * __builtin_amdgcn_rcpf(1.0f + __expf(-x)); }
__device__ __forceinline__ float logsig2(float x) { return fminf(x, 0.f) * 1.4426950408889634f - __builtin_amdgcn_logf(1.0f + __builtin_amdgcn_exp2f(-fabsf(x) * 1.4426950408889634f)); }

#define XB_TMO      128
#define XB_XCNT(j)  (256  + 64 * (j))
#define XB_XSUB(j)  (1280 + 64 * (j))
#define XB_XGEN(j)  (2304 + 64 * (j))
#define XB_TOP      3328
#define XB_TOPGEN   3392
#define XCD_BAR_WORDS 3456
#define XB_SPIN_CAP (1u << 18)
__device__ __forceinline__ unsigned xb_ld(unsigned* p)              { return __hip_atomic_load(p, __ATOMIC_RELAXED, __HIP_MEMORY_SCOPE_AGENT); }
__device__ __forceinline__ unsigned xb_add(unsigned* p, unsigned v) { return __hip_atomic_fetch_add(p, v, __ATOMIC_RELAXED, __HIP_MEMORY_SCOPE_AGENT); }
__device__ __forceinline__ unsigned xb_xcc_id() { return (unsigned)__builtin_amdgcn_s_getreg((3 << 11) | 20) & 0xFu; }
#define XB_SPIN(cond, bar) do { unsigned _sp = 0; while (cond) { __builtin_amdgcn_s_sleep(1); \
    if ((++_sp & 255u) == 0u) { if (xb_ld(&(bar)[XB_TMO])) break; if (_sp > XB_SPIN_CAP) { atomicAdd(&(bar)[XB_TMO], 1u); break; } } } } while (0)
struct XcdBarrier { unsigned* bar; unsigned x; volatile LAS unsigned* st; };
__device__ __forceinline__ XcdBarrier xcd_barrier_post(unsigned* bar, volatile LAS unsigned* st) {
    XcdBarrier b; b.bar = bar; b.x = xb_xcc_id(); b.st = st;
    if (threadIdx.x == 0) (void)xb_add(&bar[XB_XCNT(b.x)], 1u);
    return b;
}
__device__ __forceinline__ void xcd_barrier_complete(unsigned* bar, unsigned x, unsigned& nloc, unsigned& nx) {
    const unsigned G = gridDim.x * gridDim.y * gridDim.z;
    unsigned sum, cnt, mine, sp = 0u;
    for (;;) {
        sum = 0u; cnt = 0u; mine = 0u;
#pragma unroll
        for (unsigned j = 0; j < 16; ++j) { const unsigned c = xb_ld(&bar[XB_XCNT(j)]); sum += c; cnt += (c > 0u) ? 1u : 0u; mine = (j == x) ? c : mine; }
        if (sum == G) break;
        __builtin_amdgcn_s_sleep(1);
        if ((++sp & 255u) == 0u) { if (xb_ld(&bar[XB_TMO])) break; if (sp > XB_SPIN_CAP) { atomicAdd(&bar[XB_TMO], 1u); break; } }
    }
    nloc = mine > 0u ? mine : 1u; nx = cnt > 0u ? cnt : 1u;
}
__device__ __forceinline__ void xcd_barrier(const XcdBarrier& b) {
    asm volatile("s_waitcnt vmcnt(0)" ::: "memory");
    __syncthreads();
    if (threadIdx.x == 0) {
        unsigned* bar = b.bar;
        __builtin_amdgcn_s_waitcnt(0);
        unsigned nloc = b.st[0], nx = b.st[1];
        if (nloc == 0u) { xcd_barrier_complete(bar, b.x, nloc, nx); b.st[0] = nloc; b.st[1] = nx; }
        const unsigned old = xb_add(&bar[XB_XSUB(b.x)], 1u);
        const unsigned gen = old / nloc;
        if (old + 1u == (gen + 1u) * nloc) {
            __builtin_amdgcn_fence(__ATOMIC_RELEASE, "agent");
            asm volatile("s_waitcnt vmcnt(0)" ::: "memory");
            const unsigned og = xb_add(&bar[XB_TOP], 1u);
            const unsigned tg = og / nx;
            if (og + 1u == (tg + 1u) * nx) xb_add(&bar[XB_TOPGEN], 1u);
            else XB_SPIN(xb_ld(&bar[XB_TOPGEN]) == tg, bar);
            __builtin_amdgcn_fence(__ATOMIC_ACQUIRE, "agent");
            xb_add(&bar[XB_XGEN(b.x)], 1u);
            asm volatile("s_waitcnt vmcnt(0)" ::: "memory");
        } else {
            XB_SPIN(xb_ld(&bar[XB_XGEN(b.x)]) == gen, bar);
            __builtin_amdgcn_fence(__ATOMIC_ACQUIRE, "agent");
            asm volatile("s_waitcnt vmcnt(0)" ::: "memory");
        }
    }
    __syncthreads();
}

__device__ __forceinline__ int lane_id() { int l; asm volatile("v_mbcnt_lo_u32_b32 %0, -1, 0\n\tv_mbcnt_hi_u32_b32 %0, -1, %0" : "=v"(l)); return l; }
__device__ __forceinline__ int opq_s(int x) { asm volatile("" : "+s"(x)); return x; }
__device__ __forceinline__ int opq_v(int x) { asm volatile("" : "+v"(x)); return x; }
constexpr size_t WS_SSP = WS_TAB + 3 * MiB;
__device__ __forceinline__ float ss_load(const float* part, int row) {
    const f32x4* p = (const f32x4*)(part + (size_t)row * 16); const f32x4 a = p[0], b = p[1], c = p[2], d = p[3];
    return (((a[0] + a[1]) + (a[2] + a[3])) + ((b[0] + b[1]) + (b[2] + b[3]))) + (((c[0] + c[1]) + (c[2] + c[3])) + ((d[0] + d[1]) + (d[2] + d[3])));
}
using pg8::Unit; using pg8::bf16_t; using pg8::u32x4; using pg8::u32x2; using pg8::cvt_pk_bf16;
struct EpiProj {
    static constexpr bool PERM = true; static constexpr int NSTORE = 16;
    bf16_t* P; const LAS float* rstab; const float* lb; const float* bg;
    template <int MODE> __device__ __forceinline__ void run(const f32x4 (&acc)[2][2][4][2], const Unit& u, int wr, int wc, float scale, const float* aux) const {
        const int lane_e = lane_id(), fr = lane_e & 15, fq = lane_e >> 4;
        const int pn = u.pn, row0 = u.pm * 256 + wr * 64 + fr, cw = wc * 64 + 8 * fq;
        f32x4 ax[2][2];
#pragma unroll
        for (int bj = 0; bj < 2; ++bj)
#pragma unroll
            for (int n = 0; n < 2; ++n) ax[bj][n] = (MODE >= 2) ? *(const f32x4*)(aux + bj * 32 + cw + 4 * n) : (f32x4){0.f, 0.f, 0.f, 0.f};
        float rs8[2][4];
#pragma unroll
        for (int ai = 0; ai < 2; ++ai)
#pragma unroll
            for (int m = 0; m < 4; ++m) rs8[ai][m] = rstab[u.ord * 256 + wr * 64 + fr + ai * 128 + m * 16];
        if (MODE >= 2) asm volatile("s_waitcnt vmcnt(0)" ::: "memory");
#pragma unroll
        for (int ai = 0; ai < 2; ++ai)
#pragma unroll
            for (int m = 0; m < 4; ++m) {
                const int row = row0 + ai * 128 + m * 16;
                const float rs = rs8[ai][m];
                bf16_t* rowp = P + ((size_t)pn * M + row) * 256 + cw;
#pragma unroll
                for (int bj = 0; bj < 2; ++bj) {
                    float v[8];
#pragma unroll
                    for (int n = 0; n < 2; ++n) {
                        const f32x4 T = acc[ai][bj][m][n] * (MODE == 0 ? rs * scale : MODE == 3 ? rs : rs * 1.4426950408889634f); f32x4 ov;
                        if (MODE == 0) ov = T;
                        else if (MODE == 3) {
#pragma unroll
                            for (int j = 0; j < 4; ++j) ov[j] = logsig2(T[j] + ax[bj][n][j]) * 0.0625f;
                        } else { f32x4 sg;
#pragma unroll
                            for (int j = 0; j < 4; ++j) sg[j] = __builtin_amdgcn_rcpf(1.0f + __builtin_amdgcn_exp2f(-T[j]));
                            if (MODE == 1) ov = (T * sg) * (scale * 0.6931471805599453f);
                            else { const f32x4 f = ax[bj][n] + (1.0f - ax[bj][n]) * sg;
#pragma unroll
                                for (int j = 0; j < 4; ++j) ov[j] = __builtin_amdgcn_logf(fmaxf(f[j], F_MIN)); }
                        }
#pragma unroll
                        for (int j = 0; j < 4; ++j) v[n * 4 + j] = ov[j];
                    }
                    u32x4 w; w.x = cvt_pk_bf16(v[0], v[1]); w.y = cvt_pk_bf16(v[2], v[3]); w.z = cvt_pk_bf16(v[4], v[5]); w.w = cvt_pk_bf16(v[6], v[7]);
                    *(u32x4*)(rowp + bj * 32) = w;
                }
            }
    }
    __device__ __forceinline__ void operator()(const f32x4 (&acc)[2][2][4][2], const Unit& u, int wr, int wc) const {
        const int pn = u.pn;
        if (pn == 0) run<0>(acc, u, wr, wc, 0.125f, nullptr);
        else if (pn == 4 || pn == 5 || pn == 14 || pn == 15) run<1>(acc, u, wr, wc, 1.f, nullptr);
        else if (pn == 6 || pn == 7) run<1>(acc, u, wr, wc, 0.08838834764831845f, nullptr);
        else if (pn >= 8 && pn <= 11) run<2>(acc, u, wr, wc, 1.f, lb + ((pn - 8) >> 1) * 512 + ((pn - 8) & 1) * 256);
        else if (pn >= 16) run<3>(acc, u, wr, wc, 1.f, bg + (pn - 16) * 256);
        else run<0>(acc, u, wr, wc, 1.f, nullptr);
    }
};
template <int KIND> struct EpiRes {
    static constexpr bool PERM = true; static constexpr int NSTORE = 0;
    const bf16_t* hin; bf16_t* hout; float* ss_out; const float* ss_in; const bf16_t* pp; unsigned char* hq; float ascale;
    __device__ __forceinline__ void operator()(const f32x4 (&acc)[2][2][4][2], const Unit& u, int wr, int wc) const {
        const int lane_e = lane_id(), fr = lane_e & 15, fq = lane_e >> 4;
        const int row0 = u.pm * 256 + wr * 64 + fr, col0 = u.pn * 256 + wc * 32 + 8 * fq;
#pragma unroll
        for (int ai = 0; ai < 2; ++ai)
#pragma unroll
        for (int mh = 0; mh < 2; ++mh) {
            u32x4 hw[4][2], pw[4][2]; float rs4[4];
#pragma unroll
            for (int m = 2 * mh; m < 2 * mh + 2; ++m) { const int row = row0 + ai * 128 + m * 16; rs4[m] = 0.f;
                if (KIND == 1) rs4[m] = ss_load(ss_in, row);
#pragma unroll
                for (int bj = 0; bj < 2; ++bj) { const size_t off = (size_t)row * D + col0 + bj * 128; hw[m][bj] = *(const u32x4*)(hin + off); if (KIND == 1) pw[m][bj] = *(const u32x4*)(pp + off); } }
#pragma unroll
            for (int m = 2 * mh; m < 2 * mh + 2; ++m) {
                const int row = row0 + ai * 128 + m * 16; float sq = 0.f; const float rs = (KIND == 1) ? rsqrtf(rs4[m] * (1.0f / 1024.0f) + EPS) : 0.f;
#pragma unroll
                for (int bj = 0; bj < 2; ++bj) {
                    const size_t off = (size_t)row * D + col0 + bj * 128;
                    const u32x4 h_ = hw[m][bj]; const f32x4 a0 = acc[ai][bj][m][0], a1 = acc[ai][bj][m][1];
                    f32x4 h0 = (f32x4){bflo(h_.x), bfhi(h_.x), bflo(h_.y), bfhi(h_.y)}, h1 = (f32x4){bflo(h_.z), bfhi(h_.z), bflo(h_.w), bfhi(h_.w)};
                    if (KIND == 1) { const u32x4 p_ = pw[m][bj];
                        h0[0] += bflo(p_.x) * sigm(a0[0] * rs); h0[1] += bfhi(p_.x) * sigm(a0[1] * rs); h0[2] += bflo(p_.y) * sigm(a0[2] * rs); h0[3] += bfhi(p_.y) * sigm(a0[3] * rs);
                        h1[0] += bflo(p_.z) * sigm(a1[0] * rs); h1[1] += bfhi(p_.z) * sigm(a1[1] * rs); h1[2] += bflo(p_.w) * sigm(a1[2] * rs); h1[3] += bfhi(p_.w) * sigm(a1[3] * rs);
                    } else { h0 += a0 * ascale; h1 += a1 * ascale; }
                    u32x4 w; w.x = cvt_pk_bf16(h0[0], h0[1]); w.y = cvt_pk_bf16(h0[2], h0[3]); w.z = cvt_pk_bf16(h1[0], h1[1]); w.w = cvt_pk_bf16(h1[2], h1[3]); *(u32x4*)(hout + off) = w;
                    if (KIND == 0 && hq) { int q0 = 0, q1 = 0; q0 = __builtin_amdgcn_cvt_pk_fp8_f32(h0[0], h0[1], q0, false); q0 = __builtin_amdgcn_cvt_pk_fp8_f32(h0[2], h0[3], q0, true);
                        q1 = __builtin_amdgcn_cvt_pk_fp8_f32(h1[0], h1[1], q1, false); q1 = __builtin_amdgcn_cvt_pk_fp8_f32(h1[2], h1[3], q1, true); *(u32x2*)(hq + off) = (u32x2){(unsigned)q0, (unsigned)q1}; }
                    const float r0 = bflo(w.x), r1 = bfhi(w.x), r2 = bflo(w.y), r3 = bfhi(w.y), r4 = bflo(w.z), r5 = bfhi(w.z), r6 = bflo(w.w), r7 = bfhi(w.w);
                    sq += ((r0 * r0 + r1 * r1) + (r2 * r2 + r3 * r3)) + ((r4 * r4 + r5 * r5) + (r6 * r6 + r7 * r7));
                }
                sq += __builtin_bit_cast(float, __builtin_amdgcn_ds_bpermute((lane_e ^ 16) << 2, __builtin_bit_cast(int, sq))); sq += __builtin_bit_cast(float, __builtin_amdgcn_ds_bpermute((lane_e ^ 32) << 2, __builtin_bit_cast(int, sq)));
                if (fq == 0) ss_out[(size_t)row * 16 + u.pn * 4 + wc] = sq;
            }
            asm volatile("" ::: "memory");
        }
    }
};
template <bool F8OUT> struct EpiSwiGLU {
    static constexpr bool PERM = true; static constexpr int NSTORE = 8;
    bf16_t* O; int ldo; const LAS float* rstab;
    __device__ __forceinline__ void operator()(const f32x4 (&acc)[2][2][4][2], const Unit& u, int wr, int wc) const {
        const int lane_e = lane_id(), fr = lane_e & 15, fq = lane_e >> 4;
        const int row0 = u.pm * 256 + wr * 64 + fr, oc = u.pnl * 128 + wc * 32 + 8 * fq;
        float rs8[2][4];
#pragma unroll
        for (int ai = 0; ai < 2; ++ai)
#pragma unroll
            for (int m = 0; m < 4; ++m) rs8[ai][m] = rstab[u.ord * 256 + wr * 64 + fr + ai * 128 + m * 16];
#pragma unroll
        for (int ai = 0; ai < 2; ++ai)
#pragma unroll
            for (int m = 0; m < 4; ++m) {
                const int row = row0 + ai * 128 + m * 16;
                const float rs = rs8[ai][m];
                const float sg = rs * 1.4426950408889634f, su = rs * ((F8OUT ? (float)F8_AMUL : 1.0f) * 0.6931471805599453f);
                float v[8];
#pragma unroll
                for (int n = 0; n < 2; ++n) {
                    const f32x4 Gv = acc[ai][0][m][n] * sg, Uv = acc[ai][1][m][n] * su; f32x4 dn;
#pragma unroll
                    for (int j = 0; j < 4; ++j) dn[j] = __builtin_amdgcn_rcpf(1.0f + __builtin_amdgcn_exp2f(-Gv[j]));
                    const f32x4 ov = (Gv * Uv) * dn;
#pragma unroll
                    for (int j = 0; j < 4; ++j) v[n * 4 + j] = ov[j];
                }
                if (F8OUT) { int w0 = 0, w1 = 0;
                    w0 = __builtin_amdgcn_cvt_pk_fp8_f32(v[0], v[1], w0, false); w0 = __builtin_amdgcn_cvt_pk_fp8_f32(v[2], v[3], w0, true);
                    w1 = __builtin_amdgcn_cvt_pk_fp8_f32(v[4], v[5], w1, false); w1 = __builtin_amdgcn_cvt_pk_fp8_f32(v[6], v[7], w1, true);
                    *(u32x2*)((unsigned char*)O + (size_t)row * ldo + oc) = (u32x2){(unsigned)w0, (unsigned)w1}; }
                else { u32x4 w; w.x = cvt_pk_bf16(v[0], v[1]); w.y = cvt_pk_bf16(v[2], v[3]); w.z = cvt_pk_bf16(v[4], v[5]); w.w = cvt_pk_bf16(v[6], v[7]);
                    *(u32x4*)(O + (size_t)row * ldo + oc) = w; }
            }
    }
};
struct EpiScatter {
    static constexpr bool PERM = true; static constexpr int NSTORE = 0;
    bf16_t* YS; const int* ltok; const float* lw;
    __device__ __forceinline__ void operator()(const f32x4 (&acc)[2][2][4][2], const Unit& u, int wr, int wc) const {
        const int lane_e = lane_id(), fr = lane_e & 15, fq = lane_e >> 4;
        const int oc = u.pnl * 256 + wc * 32 + 8 * fq;
        int rx8[2][4]; float wg8[2][4];
#pragma unroll
        for (int ai = 0; ai < 2; ++ai)
#pragma unroll
            for (int m = 0; m < 4; ++m) { const int rl = wr * 64 + fr + ai * 128 + m * 16, ri = u.rbase + (rl < u.nvalid ? rl : u.nvalid - 1); rx8[ai][m] = ltok[ri]; wg8[ai][m] = lw[ri]; }
#pragma unroll
        for (int ai = 0; ai < 2; ++ai)
#pragma unroll
            for (int m = 0; m < 4; ++m) {
                const int rl = wr * 64 + fr + ai * 128 + m * 16;
                if (rl < u.nvalid) {
                    const int rx = rx8[ai][m]; const int tok = rx & 0xffff, rank = (rx >> 16) & 1; const float wgt = wg8[ai][m] * (1.0f / (F8_WMUL * F8_AMUL));
                    bf16_t* rowp = YS + ((size_t)rank * M + tok) * D + oc;
#pragma unroll
                    for (int bj = 0; bj < 2; ++bj) { const f32x4 a0 = acc[ai][bj][m][0] * wgt, a1 = acc[ai][bj][m][1] * wgt;
                        u32x4 w; w.x = cvt_pk_bf16(a0[0], a0[1]); w.y = cvt_pk_bf16(a0[2], a0[3]); w.z = cvt_pk_bf16(a1[0], a1[1]); w.w = cvt_pk_bf16(a1[2], a1[3]);
                        *(u32x4*)(rowp + bj * 128) = w; }
                }
            }
    }
};
struct EpiBf16Plain {
    static constexpr bool PERM = false; static constexpr int NSTORE = 0;
    bf16_t* O;
    __device__ __forceinline__ void operator()(const f32x4 (&acc)[2][2][4][2], const Unit& u, int wr, int wc) const {
        const int lane_e = lane_id(), fr = lane_e & 15, fq = lane_e >> 4;
        const int row0 = u.pm * 256 + wr * 64 + fr, col0 = u.pn * 256 + wc * 32 + 4 * fq;
#pragma unroll
        for (int ai = 0; ai < 2; ++ai)
#pragma unroll
            for (int m = 0; m < 4; ++m)
#pragma unroll
                for (int bj = 0; bj < 2; ++bj)
#pragma unroll
                    for (int n = 0; n < 2; ++n) { const f32x4 a = acc[ai][bj][m][n]; u32x2 w; w.x = cvt_pk_bf16(a[0], a[1]); w.y = cvt_pk_bf16(a[2], a[3]);
                        *(u32x2*)(O + (size_t)(row0 + ai * 128 + m * 16) * D + col0 + bj * 128 + n * 16) = w; }
    }
};


template <class Sched> __device__ __forceinline__ void fill_rs_table(LAS float* tab, const Sched& S, const float* ssp, const float* rdir, float scale, int tid, const int* ltok = nullptr) {
    pg8::Unit u;
    for (int i = 0; i < RSTAB_UNITS && S.next(i, u); i += 2) {
        pg8::Unit u2; const bool two = S.next(i + 1, u2) && (i + 1 < RSTAB_UNITS);
        const int sel = tid >> 8, rl = tid & 255;
        if (sel == 0 || two) { const int row = (sel ? u2.pm : u.pm) * 256 + rl;
            const pg8::Unit& uu = sel ? u2 : u;
            tab[(i + sel) * 256 + rl] = (rdir ? rdir[ltok[uu.rbase + (rl < uu.nvalid ? rl : uu.nvalid - 1)] & 0xffff] : rsqrtf(ss_load(ssp, row) * (1.0f / 1024.0f) + EPS)) * scale; }
    }
    __syncthreads();
}
struct Args { const float* in[22]; float* out; unsigned char* ws; int ph_lo, ph_hi; };
enum { I_X = 0, I_P, I_WIN, I_WG2, I_BG, I_LBL, I_GON, I_HON, I_WOUT, I_NMIX, I_NFFN, I_WDG, I_WDU, I_WDD, I_WR, I_WEG, I_WEU, I_WED, I_WPP, I_WPG, I_NPLE, I_NFIN };

__device__ __forceinline__ float wave_sum(float v, int lane) {
#pragma unroll
    for (int o = 1; o < 64; o <<= 1) v += __builtin_bit_cast(float, __builtin_amdgcn_ds_bpermute((lane ^ o) << 2, __builtin_bit_cast(int, v)));
    return v;
}

__device__ __forceinline__ void tr_writeout(bf16* WT, int K, int drow, int k0, LAS float* scr, int lane) {
    LDS_WAIT(); asm volatile("" ::: "memory");
    const int c = lane & 7;
#pragma unroll
    for (int j = 0; j < 4; ++j) { const int n = (lane >> 3) + 8 * j; const LAS float* s = scr + (8 * c) * 33 + n;
        v4u o; o.x = pk2(s[0 * 33], s[1 * 33]); o.y = pk2(s[2 * 33], s[3 * 33]); o.z = pk2(s[4 * 33], s[5 * 33]); o.w = pk2(s[6 * 33], s[7 * 33]);
        *(GAS v4u*)(WT + (size_t)(drow + n) * K + k0 + 8 * c) = o; }
    LDS_WAIT(); asm volatile("" ::: "memory");
}
__device__ __forceinline__ void tr_item(const float* W, int ldn, int K, int scol, bf16* WT, int drow, int k0, const float* scale, LAS float* scr, int lane) {
#pragma unroll 8
    for (int i = 0; i < 32; ++i) { const int kk = 2 * i + (lane >> 5); float v = W[(size_t)(k0 + kk) * ldn + scol + (lane & 31)]; if (scale) v *= scale[k0 + kk]; scr[kk * 33 + (lane & 31)] = v; }
    tr_writeout(WT, K, drow, k0, scr, lane);
}

struct Desc { const float* W; int ldn, K, ncols, scol0; bf16* WT; int drow0, ilv; const float* scale; float f8mul; };
constexpr int ND = 74;
typedef const __attribute__((address_space(4))) Args* KArgs;
__device__ __forceinline__ KArgs kargs() { KArgs p = (KArgs)__builtin_amdgcn_kernarg_segment_ptr(); asm volatile("" : "+s"(p)); return p; }
__device__ __forceinline__ Desc get_desc(KArgs ap, int d) {
    Desc r; unsigned char* ws = ap->ws; const float* const* in_ = nullptr; (void)in_;
    if (d < 20) { const int i = d / 5, q = d % 5;
        if (q == 0) r = Desc{ap->in[I_WIN] + (size_t)i * D * DIN, DIN, D, 1536, 0, (bf16*)(ws + WS_WIN) + (size_t)i * NPROJ * D, 0, 3, ap->in[I_NMIX] + i * D};
        else if (q == 1) r = Desc{ap->in[I_WIN] + (size_t)i * D * DIN, DIN, D, 2560, 1568, (bf16*)(ws + WS_WIN) + (size_t)i * NPROJ * D, 1536, 3, ap->in[I_NMIX] + i * D};
        else if (q == 2) r = Desc{ap->in[I_WOUT] + (size_t)i * D * D, D, D, D, 0, (bf16*)(ws + WS_WOUT) + (size_t)i * D * D, 0, 0, nullptr};
        else if (q == 3) r = Desc{ap->in[I_WPG] + (size_t)i * D * D, D, D, D, 0, (bf16*)(ws + WS_WPG) + (size_t)i * D * D, 0, 0, ap->in[I_NPLE] + i * D};
        else r = Desc{ap->in[I_WPP] + (size_t)i * PLE * D, D, PLE, D, 0, (bf16*)(ws + WS_WPP) + (size_t)i * D * PLE, 0, 0, nullptr};
    } else if (d < 26) { const int j = (d - 20) / 3, q = (d - 20) % 3;
#if F8_DENSE
        if (q == 0) r = Desc{ap->in[I_WDG] + (size_t)j * D * FFD, FFD, D, FFD, 0, (bf16*)((unsigned char*)(ws + WS_WGU) + (size_t)j * 2 * FFD * D), 0, 1, ap->in[I_NFFN] + (2 * j) * D, F8_GMUL};
        else if (q == 1) r = Desc{ap->in[I_WDU] + (size_t)j * D * FFD, FFD, D, FFD, 0, (bf16*)((unsigned char*)(ws + WS_WGU) + (size_t)j * 2 * FFD * D), 0, 2, ap->in[I_NFFN] + (2 * j) * D, F8_GMUL};
        else r = Desc{ap->in[I_WDD] + (size_t)j * FFD * D, D, FFD, D, 0, (bf16*)((unsigned char*)(ws + WS_WDN) + (size_t)j * D * FFD), 0, 0, nullptr, F8_WMUL};
#else
        if (q == 0) r = Desc{ap->in[I_WDG] + (size_t)j * D * FFD, FFD, D, FFD, 0, (bf16*)(ws + WS_WGU) + (size_t)j * 2 * FFD * D, 0, 1, ap->in[I_NFFN] + (2 * j) * D};
        else if (q == 1) r = Desc{ap->in[I_WDU] + (size_t)j * D * FFD, FFD, D, FFD, 0, (bf16*)(ws + WS_WGU) + (size_t)j * 2 * FFD * D, 0, 2, ap->in[I_NFFN] + (2 * j) * D};
#if F8_DDN
        else r = Desc{ap->in[I_WDD] + (size_t)j * FFD * D, D, FFD, D, 0, (bf16*)((unsigned char*)(ws + WS_WDN) + (size_t)j * D * FFD), 0, 0, nullptr, F8_WMUL};
#else
        else r = Desc{ap->in[I_WDD] + (size_t)j * FFD * D, D, FFD, D, 0, (bf16*)(ws + WS_WDN) + (size_t)j * D * FFD, 0, 0, nullptr};
#endif
#endif
    } else { const int je = (d - 26) / 3, q = (d - 26) % 3, j = je / 8;
#if F8_EGU
        if (q == 0) r = Desc{ap->in[I_WEG] + (size_t)je * D * FFE, FFE, D, FFE, 0, (bf16*)((unsigned char*)(ws + WS_WEGU) + (size_t)je * 2 * FFE * D), 0, 1, ap->in[I_NFFN] + (2 * j + 1) * D, F8_GMUL};
        else if (q == 1) r = Desc{ap->in[I_WEU] + (size_t)je * D * FFE, FFE, D, FFE, 0, (bf16*)((unsigned char*)(ws + WS_WEGU) + (size_t)je * 2 * FFE * D), 0, 2, ap->in[I_NFFN] + (2 * j + 1) * D, F8_GMUL};
#else
        if (q == 0) r = Desc{ap->in[I_WEG] + (size_t)je * D * FFE, FFE, D, FFE, 0, (bf16*)(ws + WS_WEGU) + (size_t)je * 2 * FFE * D, 0, 1, ap->in[I_NFFN] + (2 * j + 1) * D};
        else if (q == 1) r = Desc{ap->in[I_WEU] + (size_t)je * D * FFE, FFE, D, FFE, 0, (bf16*)(ws + WS_WEGU) + (size_t)je * 2 * FFE * D, 0, 2, ap->in[I_NFFN] + (2 * j + 1) * D};
#endif
        else r = Desc{ap->in[I_WED] + (size_t)je * FFE * D, D, FFE, D, 0, (bf16*)((unsigned char*)(ws + WS_WEDN) + (size_t)je * D * FFE), 0, 0, nullptr, F8_WMUL};
    }
    return r;
}


constexpr int ND_PRO = 50;
__device__ __forceinline__ void convert_descs(KArgs A, int d_lo, int d_hi, int gwv, int ngw, LAS float* scr, int lane) {
    struct ItemRef { const float* src; const float* sc; bf16* dst; int ldn, K; float f8; };
    int d_ = d_lo, it_ = -1, base_ = 0;
#define PRO_NEXT(ok_, ref_) do { ok_ = false; while (d_ < d_hi) { const Desc ds = get_desc(A, d_); const int nnb = ds.ncols / 32, ni = (ds.K / 64) * nnb; \
        if (it_ < 0) { int f_ = (gwv - base_) % ngw; if (f_ < 0) f_ += ngw; it_ = f_; } \
        if (it_ < ni) { const int kb = it_ / nnb, nb = it_ % nnb, c = 32 * nb; const int drow = ds.ilv == 3 ? (ds.drow0 + (c & ~255) + 32 * (4 * ((c >> 5) & 1) + ((c >> 6) & 3))) : ds.ilv ? (ds.drow0 + 256 * (c / 128) + 128 * (ds.ilv - 1) + (c % 128)) : (ds.drow0 + c); \
            ref_.src = ds.W + (size_t)(64 * kb) * ds.ldn + ds.scol0 + c; ref_.sc = ds.scale ? ds.scale + 64 * kb : nullptr; ref_.f8 = ds.f8mul; ref_.dst = ds.f8mul != 0.f ? (bf16*)((unsigned char*)ds.WT + (size_t)drow * ds.K + 64 * kb) : ds.WT + (size_t)drow * ds.K + 64 * kb; ref_.ldn = ds.ldn; ref_.K = ds.K; it_ += ngw; ok_ = true; break; } \
        base_ = (base_ + ni) % ngw; ++d_; it_ = -1; } } while (0)
#define PRO_LOAD(v_, ref_) do { const float* p_ = ref_.src + (size_t)(lane >> 5) * ref_.ldn + (lane & 31); const size_t st_ = (size_t)2 * ref_.ldn; \
        _Pragma("unroll") for (int i = 0; i < 32; ++i) v_[i] = __builtin_nontemporal_load(p_ + i * st_); } while (0)
#define PRO_PROC(v_, ref_) do { \
        _Pragma("unroll") for (int i = 0; i < 32; ++i) scr[(2 * i + (lane >> 5)) * 33 + (lane & 31)] = v_[i]; \
        LDS_WAIT(); asm volatile("" ::: "memory"); \
        const int c_ = lane & 7; f32x4 s0_ = (f32x4){1.f, 1.f, 1.f, 1.f}, s1_ = s0_; if (ref_.sc) { s0_ = *(const f32x4*)(ref_.sc + 8 * c_); s1_ = *(const f32x4*)(ref_.sc + 8 * c_ + 4); } \
        _Pragma("unroll") for (int j = 0; j < 4; ++j) { const int n_ = (lane >> 3) + 8 * j; const LAS float* s_ = scr + (8 * c_) * 33 + n_; \
            if (ref_.f8 != 0.f) { const float m_ = ref_.f8; int w0_ = 0, w1_ = 0; \
                w0_ = __builtin_amdgcn_cvt_pk_fp8_f32(s_[0 * 33] * s0_[0] * m_, s_[1 * 33] * s0_[1] * m_, w0_, false); w0_ = __builtin_amdgcn_cvt_pk_fp8_f32(s_[2 * 33] * s0_[2] * m_, s_[3 * 33] * s0_[3] * m_, w0_, true); \
                w1_ = __builtin_amdgcn_cvt_pk_fp8_f32(s_[4 * 33] * s1_[0] * m_, s_[5 * 33] * s1_[1] * m_, w1_, false); w1_ = __builtin_amdgcn_cvt_pk_fp8_f32(s_[6 * 33] * s1_[2] * m_, s_[7 * 33] * s1_[3] * m_, w1_, true); \
                __builtin_nontemporal_store((v2u){(unsigned)w0_, (unsigned)w1_}, (GAS v2u*)((unsigned char*)ref_.dst + (size_t)n_ * ref_.K + 8 * c_)); } \
            else { v4u o_; o_.x = pk2(s_[0 * 33] * s0_[0], s_[1 * 33] * s0_[1]); o_.y = pk2(s_[2 * 33] * s0_[2], s_[3 * 33] * s0_[3]); o_.z = pk2(s_[4 * 33] * s1_[0], s_[5 * 33] * s1_[1]); o_.w = pk2(s_[6 * 33] * s1_[2], s_[7 * 33] * s1_[3]); \
            __builtin_nontemporal_store(o_, (GAS v4u*)(ref_.dst + (size_t)n_ * ref_.K + 8 * c_)); } } \
        LDS_WAIT(); asm volatile("" ::: "memory"); } while (0)
    ItemRef ra, rb; bool oka, okb; float va[32], vb[32];
    PRO_NEXT(oka, ra); if (oka) PRO_LOAD(va, ra);
    while (oka) {
        PRO_NEXT(okb, rb); if (okb) PRO_LOAD(vb, rb);
        PRO_PROC(va, ra);
        if (!okb) break;
        PRO_NEXT(oka, ra); if (oka) PRO_LOAD(va, ra);
        PRO_PROC(vb, rb);
    }
#undef PRO_NEXT
#undef PRO_LOAD
#undef PRO_PROC
}

namespace scan {
typedef short s16x8 __attribute__((ext_vector_type(8)));
typedef short s16x4 __attribute__((ext_vector_type(4)));
typedef short v4i16_t __attribute__((ext_vector_type(4)));
__device__ __forceinline__ s16x4 vtr(const LAS unsigned char* p) { return __builtin_bit_cast(s16x4, __builtin_amdgcn_ds_read_tr16_b64_v4i16((LAS v4i16_t*)p)); }
__device__ __forceinline__ s16x8 cat(s16x4 a, s16x4 b) { return __builtin_shufflevector(a, b, 0, 1, 2, 3, 4, 5, 6, 7); }
__device__ __forceinline__ f32x4 mma(s16x8 a, s16x8 b, f32x4 c) { return __builtin_amdgcn_mfma_f32_16x16x32_bf16(a, b, c, 0, 0, 0); }
__device__ __forceinline__ s16x8 tri_pat(int g, int c16, int pi) { s16x8 r;
#pragma unroll
    for (int j = 0; j < 8; ++j) r[j] = (8 * g + j <= c16 + 16 * pi) ? (short)0x3F80 : (short)0;
    return r; }
__device__ __forceinline__ v2u pack4(float a, float b, float c, float d) { v2u r; r.x = pg8::cvt_pk_bf16(a, b); r.y = pg8::cvt_pk_bf16(c, d); return r; }
__device__ __forceinline__ f32x4 unpack4(v2u w) { return (f32x4){bflo(w.x), bfhi(w.x), bflo(w.y), bfhi(w.y)}; }

constexpr size_t E_G_OFF = 0, E_H_OFF = 16 * MiB, D_OFF = 48 * MiB;
__device__ __forceinline__ size_t e_index(int unit, int dir, int w, int ndt, int dt, int lane) { return ((((size_t)unit * 2 + dir) * 8 + w) * ndt + dt) * 64 + lane; }
__device__ __forceinline__ size_t d_index(int grp, int seq, int dir, int seg, int dim) { return ((((size_t)grp * 8 + seq) * 2 + dir) * 32 + seg) * 128 + dim; }

#define EX2(x) __builtin_amdgcn_exp2f(x)
__device__ __forceinline__ float dppf(float x, int ctrl_sel) {
    const int xi = __builtin_bit_cast(int, x); int r;
    if (ctrl_sel == 0) r = __builtin_amdgcn_update_dpp(0, xi, 0xB1, 0xF, 0xF, true);
    else if (ctrl_sel == 1) r = __builtin_amdgcn_update_dpp(0, xi, 0x4E, 0xF, 0xF, true);
    else if (ctrl_sel == 2) r = __builtin_amdgcn_update_dpp(0, xi, 0x141, 0xF, 0xF, true);
    else r = __builtin_amdgcn_update_dpp(0, xi, 0x140, 0xF, 0xF, true);
    return __builtin_bit_cast(float, r); }
__device__ __forceinline__ float row16_sum(float x) { x += dppf(x, 0); x += dppf(x, 1); x += dppf(x, 2); x += dppf(x, 3); return x; }
template <int DK, bool HG, bool PB>
__device__ __forceinline__ void scan_unit(const bf16* P, float* OFf, f32x4* Ebuf, float* Dbuf, bf16* Y, const float* onw, int unit, LAS unsigned char* lds, int w, int lane) {
    constexpr int RS = DK * 2 + 16, NDT = DK / 16, NKS = DK / 32, PPR = DK / 8;
    constexpr int QT = 0, GT = 64 * RS, KT = 2 * 64 * RS, VT = 3 * 64 * RS, AT = GT, VEC = VT + 64 * 272, OFL = VEC + 2 * 1536, NOFL = HG ? 3 : 4, OFC = 64 * 272, HN = 129024;
    static_assert(64 * 144 <= 64 * RS && OFL + NOFL * OFC <= HN && HN + 2048 <= 131072, "scan LDS map");
    const int lane0 = lane;
#define LDT(p_) (dir_ ? __builtin_nontemporal_load((const v4u*)(p_)) : *(const v4u*)(p_))
#define SCAN_LANE() const int ln_ = opq_v(lane0), g = ln_ >> 4, c16 = ln_ & 15, q4 = c16 >> 2, p4 = c16 & 3, tid = w * 64 + ln_; (void)g; (void)c16; (void)q4; (void)p4; (void)tid;

    const int seq = unit >> 5, seg = unit & 31, b = seq >> 2, hh = seq & 3;
    const int qc = HG ? PC_HQ + hh * 128 : PC_GQ + hh * 64, kc = PC_GK + hh * 64, vc = (HG ? PC_HV : PC_GV) + hh * 128;
#define SCAN_GATEC ((HG ? PC_HR : PC_GR) + hh * 128 + 16 * w + c16)
#define SCAN_YCOL ((HG ? 512 : 0) + hh * 128 + 16 * w + c16)
    const int tok0 = b * SEQ + seg * 256;
    const int cdt = HG ? w : (w >> 1), ctt0 = HG ? 0 : 2 * (w & 1), cntt = HG ? 4 : 2;
    f32x4 S[NDT]; f32x4 dlog = (f32x4){0.f, 0.f, 0.f, 0.f};
    v4u stq[2], stg[2], stk, stv[2];
#define SCAN_TOK(stp_, tau_) (tok0 + 64 * (((stp_) >> 2) ? 3 - ((stp_) & 3) : ((stp_) & 3)) + (((stp_) >> 2) ? 63 - (tau_) : (tau_)))
#define SCAN_ISSUE(stp_) do { const int dir_ = (stp_) >> 2; const int gcol_ = HG ? ((dir_ ? PC_HFB : PC_HFF) + hh * 128) : ((dir_ ? PC_GGB : PC_GGF) + hh * 64); \
        _Pragma("unroll") for (int i_ = 0; i_ < PPR / 8; ++i_) { const int p_ = tid + 512 * i_, row_ = p_ / PPR, ch_ = p_ % PPR; const int tk_ = SCAN_TOK(stp_, row_); const char* Pc_ = (const char*)P; \
            if (PB) stq[i_] = LDT(Pc_ + pofs(tk_, qc + 8 * ch_) * 2u); stg[i_] = LDT(Pc_ + pofs(tk_, gcol_ + 8 * ch_) * 2u); if (!HG) stk = LDT(Pc_ + pofs(tk_, kc + 8 * ch_) * 2u); } \
        _Pragma("unroll") for (int i_ = 0; i_ < 2; ++i_) { const int p_ = tid + 512 * i_, row_ = p_ >> 4, ch_ = p_ & 15; stv[i_] = LDT((const char*)P + pofs(SCAN_TOK(stp_, row_), vc + 8 * ch_) * 2u); } } while (0)
#define SCAN_WRITE() do { \
        _Pragma("unroll") for (int i_ = 0; i_ < PPR / 8; ++i_) { const int p_ = tid + 512 * i_, row_ = p_ / PPR, ch_ = p_ % PPR; \
            if (PB) *(LAS v4u*)(lds + QT + row_ * RS + ch_ * 16) = stq[i_]; *(LAS v4u*)(lds + GT + row_ * RS + ch_ * 16) = stg[i_]; if (!HG) *(LAS v4u*)(lds + KT + row_ * RS + ch_ * 16) = stk; } \
        _Pragma("unroll") for (int i_ = 0; i_ < 2; ++i_) { const int p_ = tid + 512 * i_, row_ = p_ >> 4, ch_ = p_ & 15; *(LAS v4u*)(lds + VT + row_ * 272 + ch_ * 16) = stv[i_]; } } while (0)
    { SCAN_LANE() SCAN_ISSUE(0); }
    f32x4 okeep[4];
#pragma unroll
    for (int tm = 0; tm < 4; ++tm) okeep[tm] = (f32x4){0.f, 0.f, 0.f, 0.f};
    for (int stp = 0; stp < 8; ++stp) {
        const int dir = stp >> 2, ci = stp & 3;
        if (ci == 0) {
#pragma unroll
            for (int dt = 0; dt < NDT; ++dt) S[dt] = PB ? unpack4(((const v2u*)Ebuf)[e_index(unit, dir, w, NDT, dt, lane0)]) : (f32x4){0.f, 0.f, 0.f, 0.f};
            dlog = (f32x4){0.f, 0.f, 0.f, 0.f};
        }
        { SCAN_LANE() SCAN_WRITE(); }
        asm volatile("" ::: "memory");
        if (stp < 7) { SCAN_LANE() SCAN_ISSUE(stp + 1); }
        asm volatile("" ::: "memory");
        f32x4 o[4]; bf16 gate[16];
        if (PB) {
            SCAN_LANE()
#pragma unroll
            for (int tm = 0; tm < 4; ++tm) { o[tm] = (f32x4){0.f, 0.f, 0.f, 0.f};
                if (dir) {
                    if (3 - ci < NOFL) {
#pragma unroll
                        for (int e = 0; e < 4; ++e) o[tm][e] = bf1(*(const LAS bf16*)(lds + OFL + (3 - ci) * OFC + (63 - 4 * g) * 272 + (16 * w + c16) * 2 - (16 * tm + e) * 272));
                    } else {
#pragma unroll
                        for (int e = 0; e < 4; ++e) { float src_ = okeep[3 - tm][3 - e]; asm volatile("" : "+v"(src_)); o[tm][e] = __builtin_bit_cast(float, __builtin_amdgcn_ds_bpermute(((3 - g) * 16 + c16) << 2, __builtin_bit_cast(int, src_))); } } } }
            if (dir) {
#pragma unroll
                for (int tm = 0; tm < 4; ++tm)
#pragma unroll
                    for (int e = 0; e < 4; ++e) gate[tm * 4 + e] = *(const bf16*)((const char*)P + (pofs(SCAN_TOK(stp, 4 * g), SCAN_GATEC) * 2u - (unsigned)((16 * tm + e) * 256 * 2)));
            }
        }
        __syncthreads();
        LAS unsigned char* vecb = lds + VEC + (stp & 1) * 1536;
        {
            SCAN_LANE()
            const s16x8 pat0 = tri_pat(g, c16, 0), pat1 = tri_pat(g, c16, 1);
            const int one2 = opq_v(0x3f803f80);
            const s16x8 ones = __builtin_bit_cast(s16x8, (v4u){(unsigned)one2, (unsigned)one2, (unsigned)one2, (unsigned)one2});
            s16x8 ga[2];
#pragma unroll
            for (int ks = 0; ks < 2; ++ks) ga[ks] = cat(vtr(lds + GT + (32 * ks + 8 * g + q4) * RS + (16 * cdt + 4 * p4) * 2), vtr(lds + GT + (32 * ks + 8 * g + 4 + q4) * RS + (16 * cdt + 4 * p4) * 2));
            const f32x4 z4 = (f32x4){0.f, 0.f, 0.f, 0.f};
            const f32x4 r = mma(ga[0], ones, z4), bl = mma(ga[1], ones, r);
#pragma unroll
            for (int ti = 0; ti < cntt; ++ti) { const int tt = ctt0 + ti;
                f32x4 bb;
                if (tt < 2) bb = mma(ga[0], (tt & 1) ? pat1 : pat0, z4); else bb = mma(ga[1], (tt & 1) ? pat1 : pat0, r);
                const int off = (16 * tt + c16) * RS + (16 * cdt + 4 * g) * 2;
                if (PB) {
                    const v2u qw = *(const LAS v2u*)(lds + QT + off);
                    const float e0 = EX2(bb[0] - r[0]), e1 = EX2(bb[1] - r[1]), e2 = EX2(bb[2] - r[2]), e3 = EX2(bb[3] - r[3]);
                    *(LAS v2u*)(lds + QT + off) = pack4(bflo(qw.x) * e0, bfhi(qw.x) * e1, bflo(qw.y) * e2, bfhi(qw.y) * e3);
                }
                float k0, k1, k2, k3;
                if (HG) { const v2u gw = *(const LAS v2u*)(lds + GT + off); k0 = 1.0f - EX2(bflo(gw.x)); k1 = 1.0f - EX2(bfhi(gw.x)); k2 = 1.0f - EX2(bflo(gw.y)); k3 = 1.0f - EX2(bfhi(gw.y)); }
                else { const v2u kw = *(const LAS v2u*)(lds + KT + off); k0 = bflo(kw.x); k1 = bfhi(kw.x); k2 = bflo(kw.y); k3 = bfhi(kw.y); }
                const f32x4 ref = PB ? r : bl;
                *(LAS v2u*)(lds + KT + off) = pack4(k0 * EX2(ref[0] - bb[0]), k1 * EX2(ref[1] - bb[1]), k2 * EX2(ref[2] - bb[2]), k3 * EX2(ref[3] - bb[3]));
            }
            if (c16 == 0 && (HG || (w & 1) == 0)) {
                LAS f32x4* vp = (LAS f32x4*)(vecb + (16 * cdt + 4 * g) * 4);
                vp[0] = (f32x4){EX2(r[0]), EX2(r[1]), EX2(r[2]), EX2(r[3])};
                vp[32] = (f32x4){EX2(bl[0]), EX2(bl[1]), EX2(bl[2]), EX2(bl[3])};
                vp[64] = (f32x4){EX2(bl[0] - r[0]), EX2(bl[1] - r[1]), EX2(bl[2] - r[2]), EX2(bl[3] - r[3])};
            }
            dlog += bl;
        }
        __syncthreads();
        if (PB) {
            { SCAN_LANE()
#pragma unroll
            for (int ii = 0; ii < 2; ++ii) { const int idx = 2 * w + ii, sn = idx >> 2, tm = idx & 3;
                v2u wv = (v2u){0u, 0u};
                if (sn <= tm) {
                    f32x4 a = (f32x4){0.f, 0.f, 0.f, 0.f};
#pragma unroll
                    for (int ks = 0; ks < NKS; ++ks) a = mma(*(const LAS s16x8*)(lds + KT + (16 * sn + c16) * RS + (32 * ks + 8 * g) * 2), *(const LAS s16x8*)(lds + QT + (16 * tm + c16) * RS + (32 * ks + 8 * g) * 2), a);
                    if (sn == tm) {
#pragma unroll
                        for (int e = 0; e < 4; ++e) a[e] = (4 * g + e <= c16) ? a[e] : 0.f;
                    }
                    wv = pack4(a[0], a[1], a[2], a[3]);
                }
                *(LAS v2u*)(lds + AT + (16 * tm + c16) * 144 + (16 * sn + 4 * g) * 2) = wv;
            } }
        }
        {
            SCAN_LANE()
            s16x8 vf[2];
#pragma unroll
            for (int ks = 0; ks < 2; ++ks) vf[ks] = cat(vtr(lds + VT + (32 * ks + 8 * g + q4) * 272 + (16 * w + 4 * p4) * 2), vtr(lds + VT + (32 * ks + 8 * g + 4 + q4) * 272 + (16 * w + 4 * p4) * 2));
            if (PB) {
#pragma unroll
                for (int ks = 0; ks < NKS; ++ks) {
                    const f32x4 e0 = *(const LAS f32x4*)(vecb + (32 * ks + 4 * g) * 4), e1 = *(const LAS f32x4*)(vecb + (32 * ks + 16 + 4 * g) * 4);
                    const f32x4 s0 = S[2 * ks] * e0, s1 = S[2 * ks + 1] * e1;
                    const v2u lo = pack4(s0[0], s0[1], s0[2], s0[3]), hi = pack4(s1[0], s1[1], s1[2], s1[3]);
                    const s16x8 bS = __builtin_bit_cast(s16x8, (v4u){lo.x, lo.y, hi.x, hi.y});
#pragma unroll
                    for (int tm = 0; tm < 4; ++tm) { const LAS unsigned char* qp = lds + QT + (16 * tm + c16) * RS + (32 * ks + 4 * g) * 2;
                        const v2u a0 = *(const LAS v2u*)qp, a1 = *(const LAS v2u*)(qp + 32);
                        o[tm] = mma(__builtin_bit_cast(s16x8, (v4u){a0.x, a0.y, a1.x, a1.y}), bS, o[tm]); }
                }
            }
#pragma unroll
            for (int dt = 0; dt < NDT; ++dt) {
                f32x4 U = (f32x4){0.f, 0.f, 0.f, 0.f};
#pragma unroll
                for (int ks = 0; ks < 2; ++ks) U = mma(cat(vtr(lds + KT + (32 * ks + 8 * g + q4) * RS + (16 * dt + 4 * p4) * 2), vtr(lds + KT + (32 * ks + 8 * g + 4 + q4) * RS + (16 * dt + 4 * p4) * 2)), vf[ks], U);
                const f32x4 el = *(const LAS f32x4*)(vecb + 512 + (16 * dt + 4 * g) * 4);
                if (PB) { const f32x4 elr = *(const LAS f32x4*)(vecb + 1024 + (16 * dt + 4 * g) * 4); S[dt] = el * S[dt] + elr * U; }
                else S[dt] = el * S[dt] + U;
            }
            if (PB) {
                __syncthreads();
#pragma unroll
                for (int tm = 0; tm < 4; ++tm)
#pragma unroll
                    for (int ks = 0; ks <= (tm >> 1); ++ks) o[tm] = mma(*(const LAS s16x8*)(lds + AT + (16 * tm + c16) * 144 + (32 * ks + 8 * g) * 2), vf[ks], o[tm]);
            }
        }
        if (PB) {
            SCAN_LANE()
            if (dir == 0) {
#pragma unroll
                for (int tm = 0; tm < 4; ++tm) {
                    if (ci < NOFL) {
#pragma unroll
                        for (int e = 0; e < 4; ++e) *(LAS bf16*)(lds + OFL + ci * OFC + (4 * g) * 272 + (16 * w + c16) * 2 + (16 * tm + e) * 272) = (bf16)pg8::cvt_pk_bf16(o[tm][e], 0.f);
                    } else okeep[tm] = o[tm]; }
                __syncthreads();
            } else {
#pragma unroll
                for (int tm = 0; tm < 4; ++tm) { f32x4 sq = o[tm] * o[tm];
#pragma unroll
                    for (int e = 0; e < 4; ++e) sq[e] = row16_sum(sq[e]);
                    if (c16 == 0) {
#pragma unroll
                        for (int e = 0; e < 4; ++e) *(LAS float*)(lds + HN + ((16 * tm + 4 * g + e) * 8 + w) * 4) = sq[e]; }
                }
                __syncthreads();
                const float wv = onw[16 * w + c16];
#pragma unroll
                for (int tm = 0; tm < 4; ++tm) { asm volatile("" ::: "memory");
#pragma unroll
                    for (int e = 0; e < 4; ++e) { const int tau = 16 * tm + 4 * g + e; const f32x4 h0 = *(const LAS f32x4*)(lds + HN + tau * 32), h1 = *(const LAS f32x4*)(lds + HN + tau * 32 + 16);
                        const f32x4 h4 = h0 + h1; const pg8::f32x2_t h2 = __builtin_shufflevector(h4, h4, 0, 1) + __builtin_shufflevector(h4, h4, 2, 3);
                        const float tot = h2[0] + h2[1]; const float rn = __builtin_amdgcn_rsqf(tot * (1.0f / 128.0f) + HEAD_EPS);
                        *(bf16*)((char*)Y + ((unsigned)((SCAN_TOK(stp, 4 * g) * D + SCAN_YCOL) * 2) - (unsigned)((16 * tm + e) * D * 2))) = (bf16)pg8::cvt_pk_bf16(o[tm][e] * rn * wv * bf1(gate[tm * 4 + e]), 0.f); } }
            }
        } else {
            if (ci == 3) {
                SCAN_LANE()
#pragma unroll
                for (int dt = 0; dt < NDT; ++dt) ((v2u*)Ebuf)[e_index(unit, dir, w, NDT, dt, lane0)] = pack4(S[dt][0], S[dt][1], S[dt][2], S[dt][3]);
                if (c16 == 0 && (HG || (w & 1) == 0)) *(f32x4*)(Dbuf + d_index(HG ? 1 : 0, seq, dir, seg, 16 * cdt + 4 * g)) = (f32x4){EX2(dlog[0]), EX2(dlog[1]), EX2(dlog[2]), EX2(dlog[3])};
            }
            __syncthreads();
        }
    }
#undef SCAN_LANE
#undef SCAN_GATEC
#undef SCAN_YCOL
#undef SCAN_TOK
#undef SCAN_ISSUE
#undef SCAN_WRITE
#undef LDT
}
template <int DK, bool HG, bool PB, int LB, int HNO> struct Strm {
    static constexpr int RS = DK * 2 + 16, NDT = DK / 16, NKS = DK / 32, PPR = DK / 8;
    static constexpr int QT = LB, GT = LB + 64 * RS, KT = LB + 2 * 64 * RS, VT = LB + 3 * 64 * RS, AT = GT, VEC = VT + 64 * 272, END = VEC + 2 * 1536, HN = HNO;
    static_assert(64 * 144 <= 64 * RS, "score tile fits in the decay tile");
    f32x4 S[NDT]; f32x4 dlog; v4u stq[2], stg[2], stk, stv[2]; f32x4 o[4], ofw[4]; bf16 gate[16]; s16x8 vf[2];
    int hh, tok0, unit, w, lane0, layer; LAS unsigned char* lds;
#define ST_P ((const bf16*)(kargs()->ws + WS_BIG))
#define ST_OF ((float*)(kargs()->ws + WS_YS))
#define ST_E ((f32x4*)(kargs()->ws + WS_XG + (HG ? E_H_OFF : E_G_OFF)))
#define ST_D ((float*)(kargs()->ws + WS_XG + D_OFF))
#define ST_Y ((bf16*)(kargs()->ws + WS_Y))
#define SCAN_LANE() const int ln_ = opq_v(lane0), g = ln_ >> 4, c16 = ln_ & 15, q4 = c16 >> 2, p4 = c16 & 3, tid = w * 64 + ln_; (void)g; (void)c16; (void)q4; (void)p4; (void)tid;
#define SCAN_GATEC ((HG ? PC_HR : PC_GR) + hh * 128 + 16 * w + c16)
#define SCAN_YCOL ((HG ? 512 : 0) + hh * 128 + 16 * w + c16)
#define SCAN_TOK(stp_, tau_) (tok0 + 64 * (((stp_) >> 2) ? 3 - ((stp_) & 3) : ((stp_) & 3)) + (((stp_) >> 2) ? 63 - (tau_) : (tau_)))
    __device__ __forceinline__ void issue(int stp, int tid) {
        const int qc = HG ? PC_HQ + hh * 128 : PC_GQ + hh * 64, kc = PC_GK + hh * 64, vc = (HG ? PC_HV : PC_GV) + hh * 128;
        const int dir_ = stp >> 2; const int gcol_ = HG ? ((dir_ ? PC_HFB : PC_HFF) + hh * 128) : ((dir_ ? PC_GGB : PC_GGF) + hh * 64); const char* Pc_ = (const char*)ST_P;
#pragma unroll
        for (int i_ = 0; i_ < PPR / 8; ++i_) { const int p_ = tid + 512 * i_, row_ = p_ / PPR, ch_ = p_ % PPR; const int tk_ = SCAN_TOK(stp, row_);
            if (PB) stq[i_] = *(const v4u*)(Pc_ + pofs(tk_, qc + 8 * ch_) * 2u); stg[i_] = *(const v4u*)(Pc_ + pofs(tk_, gcol_ + 8 * ch_) * 2u); if (!HG) stk = *(const v4u*)(Pc_ + pofs(tk_, kc + 8 * ch_) * 2u); }
#pragma unroll
        for (int i_ = 0; i_ < 2; ++i_) { const int p_ = tid + 512 * i_, row_ = p_ >> 4, ch_ = p_ & 15; stv[i_] = *(const v4u*)(Pc_ + pofs(SCAN_TOK(stp, row_), vc + 8 * ch_) * 2u); }
    }
    __device__ __forceinline__ void init(int unit_, int layer_, LAS unsigned char* lds_, int w_, int lane_) {
        unit = unit_; layer = layer_; lds = lds_; w = w_; lane0 = lane_;
        const int seq = unit >> 5, seg = unit & 31, b = seq >> 2; hh = seq & 3; tok0 = b * SEQ + seg * 256;
        dlog = (f32x4){0.f, 0.f, 0.f, 0.f};
        { SCAN_LANE() issue(0, tid); }
    }
    __device__ __forceinline__ void pre(int stp) {
        const int dir = stp >> 2, ci = stp & 3;
        if (ci == 0) {
#pragma unroll
            for (int dt = 0; dt < NDT; ++dt) S[dt] = PB ? unpack4(((const v2u*)ST_E)[e_index(unit, dir, w, NDT, dt, lane0)]) : (f32x4){0.f, 0.f, 0.f, 0.f};
            dlog = (f32x4){0.f, 0.f, 0.f, 0.f};
        }
        { SCAN_LANE()
#pragma unroll
          for (int i_ = 0; i_ < PPR / 8; ++i_) { const int p_ = tid + 512 * i_, row_ = p_ / PPR, ch_ = p_ % PPR;
              if (PB) *(LAS v4u*)(lds + QT + row_ * RS + ch_ * 16) = stq[i_]; *(LAS v4u*)(lds + GT + row_ * RS + ch_ * 16) = stg[i_]; if (!HG) *(LAS v4u*)(lds + KT + row_ * RS + ch_ * 16) = stk; }
#pragma unroll
          for (int i_ = 0; i_ < 2; ++i_) { const int p_ = tid + 512 * i_, row_ = p_ >> 4, ch_ = p_ & 15; *(LAS v4u*)(lds + VT + row_ * 272 + ch_ * 16) = stv[i_]; } }
        asm volatile("" ::: "memory");
        if (stp < 7) { SCAN_LANE() issue(stp + 1, tid); }
        asm volatile("" ::: "memory");
    }
    __device__ __forceinline__ void stC(int stp) {
        LAS unsigned char* vecb = lds + VEC + (stp & 1) * 1536;
        const int cdt = HG ? w : (w >> 1), ctt0 = HG ? 0 : 2 * (w & 1), cntt = HG ? 4 : 2;
        SCAN_LANE()
        const s16x8 pat0 = tri_pat(g, c16, 0), pat1 = tri_pat(g, c16, 1);
        const int one2 = opq_v(0x3f803f80);
        const s16x8 ones = __builtin_bit_cast(s16x8, (v4u){(unsigned)one2, (unsigned)one2, (unsigned)one2, (unsigned)one2});
        s16x8 ga[2];
#pragma unroll
        for (int ks = 0; ks < 2; ++ks) ga[ks] = cat(vtr(lds + GT + (32 * ks + 8 * g + q4) * RS + (16 * cdt + 4 * p4) * 2), vtr(lds + GT + (32 * ks + 8 * g + 4 + q4) * RS + (16 * cdt + 4 * p4) * 2));
        const f32x4 z4 = (f32x4){0.f, 0.f, 0.f, 0.f};
        const f32x4 r = mma(ga[0], ones, z4), bl = mma(ga[1], ones, r);
#pragma unroll
        for (int ti = 0; ti < cntt; ++ti) { const int tt = ctt0 + ti;
            f32x4 bb;
            if (tt < 2) bb = mma(ga[0], (tt & 1) ? pat1 : pat0, z4); else bb = mma(ga[1], (tt & 1) ? pat1 : pat0, r);
            const int off = (16 * tt + c16) * RS + (16 * cdt + 4 * g) * 2;
            if (PB) {
                const v2u qw = *(const LAS v2u*)(lds + QT + off);
                const float e0 = EX2(bb[0] - r[0]), e1 = EX2(bb[1] - r[1]), e2 = EX2(bb[2] - r[2]), e3 = EX2(bb[3] - r[3]);
                *(LAS v2u*)(lds + QT + off) = pack4(bflo(qw.x) * e0, bfhi(qw.x) * e1, bflo(qw.y) * e2, bfhi(qw.y) * e3);
            }
            float k0, k1, k2, k3;
            if (HG) { const v2u gw = *(const LAS v2u*)(lds + GT + off); k0 = 1.0f - EX2(bflo(gw.x)); k1 = 1.0f - EX2(bfhi(gw.x)); k2 = 1.0f - EX2(bflo(gw.y)); k3 = 1.0f - EX2(bfhi(gw.y)); }
            else { const v2u kw = *(const LAS v2u*)(lds + KT + off); k0 = bflo(kw.x); k1 = bfhi(kw.x); k2 = bflo(kw.y); k3 = bfhi(kw.y); }
            const f32x4 ref = PB ? r : bl;
            *(LAS v2u*)(lds + KT + off) = pack4(k0 * EX2(ref[0] - bb[0]), k1 * EX2(ref[1] - bb[1]), k2 * EX2(ref[2] - bb[2]), k3 * EX2(ref[3] - bb[3]));
        }
        if (c16 == 0 && (HG || (w & 1) == 0)) {
            LAS f32x4* vp = (LAS f32x4*)(vecb + (16 * cdt + 4 * g) * 4);
            vp[0] = (f32x4){EX2(r[0]), EX2(r[1]), EX2(r[2]), EX2(r[3])};
            vp[32] = (f32x4){EX2(bl[0]), EX2(bl[1]), EX2(bl[2]), EX2(bl[3])};
            vp[64] = (f32x4){EX2(bl[0] - r[0]), EX2(bl[1] - r[1]), EX2(bl[2] - r[2]), EX2(bl[3] - r[3])};
        }
        dlog += bl;
    }
    __device__ __forceinline__ void stS(int stp) {
        SCAN_LANE()
#pragma unroll
        for (int ii = 0; ii < 2; ++ii) { const int idx = 2 * w + ii, sn = idx >> 2, tm = idx & 3;
            v2u wv = (v2u){0u, 0u};
            if (sn <= tm) {
                f32x4 a = (f32x4){0.f, 0.f, 0.f, 0.f};
#pragma unroll
                for (int ks = 0; ks < NKS; ++ks) a = mma(*(const LAS s16x8*)(lds + KT + (16 * sn + c16) * RS + (32 * ks + 8 * g) * 2), *(const LAS s16x8*)(lds + QT + (16 * tm + c16) * RS + (32 * ks + 8 * g) * 2), a);
                if (sn == tm) {
#pragma unroll
                    for (int e = 0; e < 4; ++e) a[e] = (4 * g + e <= c16) ? a[e] : 0.f;
                }
                wv = pack4(a[0], a[1], a[2], a[3]);
            }
            *(LAS v2u*)(lds + AT + (16 * tm + c16) * 144 + (16 * sn + 4 * g) * 2) = wv;
        }
    }
    __device__ __forceinline__ void stO1(int stp) {
        const int dir = stp >> 2;
        LAS unsigned char* vecb = lds + VEC + (stp & 1) * 1536;
        SCAN_LANE()
        if (PB && dir) {
#pragma unroll
            for (int tm = 0; tm < 4; ++tm)
#pragma unroll
                for (int e = 0; e < 4; ++e) ofw[tm][e] = *(const float*)((const char*)ST_OF + ((unsigned)((SCAN_TOK(stp, 4 * g) * D + SCAN_YCOL) * 4) - (unsigned)((16 * tm + e) * D * 4)));
#pragma unroll
            for (int tm = 0; tm < 4; ++tm)
#pragma unroll
                for (int e = 0; e < 4; ++e) gate[tm * 4 + e] = *(const bf16*)((const char*)ST_P + (pofs(SCAN_TOK(stp, 4 * g), SCAN_GATEC) * 2u - (unsigned)((16 * tm + e) * 256 * 2)));
        }
#pragma unroll
        for (int ks = 0; ks < 2; ++ks) vf[ks] = cat(vtr(lds + VT + (32 * ks + 8 * g + q4) * 272 + (16 * w + 4 * p4) * 2), vtr(lds + VT + (32 * ks + 8 * g + 4 + q4) * 272 + (16 * w + 4 * p4) * 2));
        if (PB) {
#pragma unroll
            for (int tm = 0; tm < 4; ++tm) o[tm] = (f32x4){0.f, 0.f, 0.f, 0.f};
#pragma unroll
            for (int ks = 0; ks < NKS; ++ks) {
                const f32x4 e0 = *(const LAS f32x4*)(vecb + (32 * ks + 4 * g) * 4), e1 = *(const LAS f32x4*)(vecb + (32 * ks + 16 + 4 * g) * 4);
                const f32x4 s0 = S[2 * ks] * e0, s1 = S[2 * ks + 1] * e1;
                const v2u lo = pack4(s0[0], s0[1], s0[2], s0[3]), hi = pack4(s1[0], s1[1], s1[2], s1[3]);
                const s16x8 bS = __builtin_bit_cast(s16x8, (v4u){lo.x, lo.y, hi.x, hi.y});
#pragma unroll
                for (int tm = 0; tm < 4; ++tm) { const LAS unsigned char* qp = lds + QT + (16 * tm + c16) * RS + (32 * ks + 4 * g) * 2;
                    const v2u a0 = *(const LAS v2u*)qp, a1 = *(const LAS v2u*)(qp + 32);
                    o[tm] = mma(__builtin_bit_cast(s16x8, (v4u){a0.x, a0.y, a1.x, a1.y}), bS, o[tm]); }
            }
        }
#pragma unroll
        for (int dt = 0; dt < NDT; ++dt) {
            f32x4 U = (f32x4){0.f, 0.f, 0.f, 0.f};
#pragma unroll
            for (int ks = 0; ks < 2; ++ks) U = mma(cat(vtr(lds + KT + (32 * ks + 8 * g + q4) * RS + (16 * dt + 4 * p4) * 2), vtr(lds + KT + (32 * ks + 8 * g + 4 + q4) * RS + (16 * dt + 4 * p4) * 2)), vf[ks], U);
            const f32x4 el = *(const LAS f32x4*)(vecb + 512 + (16 * dt + 4 * g) * 4);
            if (PB) { const f32x4 elr = *(const LAS f32x4*)(vecb + 1024 + (16 * dt + 4 * g) * 4); S[dt] = el * S[dt] + elr * U; }
            else S[dt] = el * S[dt] + U;
        }
    }
    __device__ __forceinline__ void stO2(int stp) {
        SCAN_LANE()
#pragma unroll
        for (int tm = 0; tm < 4; ++tm)
#pragma unroll
            for (int ks = 0; ks <= (tm >> 1); ++ks) o[tm] = mma(*(const LAS s16x8*)(lds + AT + (16 * tm + c16) * 144 + (32 * ks + 8 * g) * 2), vf[ks], o[tm]);
    }
    __device__ __forceinline__ void fin0(int stp) {
        SCAN_LANE()
#pragma unroll
        for (int tm = 0; tm < 4; ++tm)
#pragma unroll
            for (int e = 0; e < 4; ++e) *(float*)((char*)ST_OF + ((unsigned)((SCAN_TOK(stp, 4 * g) * D + SCAN_YCOL) * 4) + (unsigned)((16 * tm + e) * D * 4))) = o[tm][e];
    }
    __device__ __forceinline__ void fin1a(int stp) {
        SCAN_LANE()
#pragma unroll
        for (int tm = 0; tm < 4; ++tm) { o[tm] += ofw[tm]; f32x4 sq = o[tm] * o[tm];
#pragma unroll
            for (int e = 0; e < 4; ++e) sq[e] = row16_sum(sq[e]);
            if (c16 == 0) {
#pragma unroll
                for (int e = 0; e < 4; ++e) *(LAS float*)(lds + HN + ((16 * tm + 4 * g + e) * 8 + w) * 4) = sq[e]; }
        }
    }
    __device__ __forceinline__ void fin1b(int stp) {
        SCAN_LANE()
        const float wv = (kargs()->in[HG ? I_HON : I_GON] + layer * 128)[16 * w + c16];
#pragma unroll
        for (int tm = 0; tm < 4; ++tm) { asm volatile("" ::: "memory");
#pragma unroll
            for (int e = 0; e < 4; ++e) { const int tau = 16 * tm + 4 * g + e; const f32x4 h0 = *(const LAS f32x4*)(lds + HN + tau * 32), h1 = *(const LAS f32x4*)(lds + HN + tau * 32 + 16);
                const f32x4 h4 = h0 + h1; const pg8::f32x2_t h2 = __builtin_shufflevector(h4, h4, 0, 1) + __builtin_shufflevector(h4, h4, 2, 3);
                const float tot = h2[0] + h2[1]; const float rn = __builtin_amdgcn_rsqf(tot * (1.0f / 128.0f) + HEAD_EPS);
                *(bf16*)((char*)ST_Y + ((unsigned)((SCAN_TOK(stp, 4 * g) * D + SCAN_YCOL) * 2) - (unsigned)((16 * tm + e) * D * 2))) = (bf16)pg8::cvt_pk_bf16(o[tm][e] * rn * wv * bf1(gate[tm * 4 + e]), 0.f); } }
    }
    __device__ __forceinline__ void finA(int dir) {
        const int cdt = HG ? w : (w >> 1); const int seq = unit >> 5, seg = unit & 31;
        SCAN_LANE()
#pragma unroll
        for (int dt = 0; dt < NDT; ++dt) ((v2u*)ST_E)[e_index(unit, dir, w, NDT, dt, lane0)] = pack4(S[dt][0], S[dt][1], S[dt][2], S[dt][3]);
        if (c16 == 0 && (HG || (w & 1) == 0)) *(f32x4*)(ST_D + d_index(HG ? 1 : 0, seq, dir, seg, 16 * cdt + 4 * g)) = (f32x4){EX2(dlog[0]), EX2(dlog[1]), EX2(dlog[2]), EX2(dlog[3])};
    }
#undef SCAN_LANE
#undef SCAN_GATEC
#undef SCAN_YCOL
#undef SCAN_TOK
#undef ST_P
#undef ST_OF
#undef ST_E
#undef ST_D
#undef ST_Y
};
constexpr int PAIR_G_LB = 0, PAIR_H_LB = 3 * 64 * 144 + 64 * 272 + 3072, PAIR_HN_G = PAIR_H_LB + 3 * 64 * 272 + 64 * 272 + 3072, PAIR_HN_H = PAIR_HN_G + 2048;
static_assert(PAIR_HN_H + 2048 <= 131072, "pair LDS map");
template <bool PB> __device__ __forceinline__ void scan_pair(int unit, int layer, LAS unsigned char* lds, int w, int lane) {
    Strm<64, false, PB, PAIR_G_LB, PAIR_HN_G> Gs; Strm<128, true, PB, PAIR_H_LB, PAIR_HN_H> Hs;
    static_assert(Strm<64, false, PB, PAIR_G_LB, PAIR_HN_G>::END <= PAIR_H_LB && Strm<128, true, PB, PAIR_H_LB, PAIR_HN_H>::END <= PAIR_HN_G, "pair LDS map");
    Gs.init(unit, layer, lds, w, lane); Hs.init(unit, layer, lds, w, lane);
    for (int stp = 0; stp < 8; ++stp) {
        const int dir = stp >> 2, ci = stp & 3;
        Gs.pre(stp); Hs.pre(stp);
        __syncthreads();
        Gs.stC(stp); Hs.stC(stp);
        __syncthreads();
        if (PB) { Gs.stS(stp); Hs.stS(stp); }
        Gs.stO1(stp); Hs.stO1(stp);
        if (PB) {
            __syncthreads();
            Gs.stO2(stp); Hs.stO2(stp);
            if (dir == 0) { Gs.fin0(stp); Hs.fin0(stp); if (ci == 3) VM_WAIT(); __syncthreads(); }
            else { Gs.fin1a(stp); Hs.fin1a(stp); __syncthreads(); Gs.fin1b(stp); Hs.fin1b(stp); }
        } else { if (ci == 3) { Gs.finA(dir); Hs.finA(dir); } __syncthreads(); }
    }
}
}

#define WSP(T, off) ((T*)(A->ws + (off)))
#define FILLER(U_, lo_, hi_) do { int rem_ = opq_s(U_) % G; if (2 * (G - rem_) < G) rem_ = 0;     \
    if (rem_ == 0 || bx >= rem_) { const int P_ = rem_ == 0 ? G : G - rem_, r_ = rem_ == 0 ? bx : bx - rem_; \
        convert_descs(A, (lo_), (hi_), r_ * NWAVES + wave, P_ * NWAVES, (LAS float*)(lds + RING_OFF + wave * 16384), lane_id()); } } while (0)
#define PP_TAIL(U_) do { int rem_ = opq_s(U_) % G; if (2 * (G - rem_) < G) rem_ = 0; if (rem_ == 0 || bx >= rem_) { const int P_ = rem_ == 0 ? G : G - rem_, r_ = rem_ == 0 ? bx : bx - rem_; \
        pg8::Gemm gp_{WSP(bf16, WS_PB) + (size_t)layer * M * PLE, WSP(bf16, WS_WPP) + (size_t)layer * D * PLE, PLE}; pg8::StaticOrder Sp_; Sp_.init(M, D, P_, r_); EpiBf16Plain Ep_{WSP(bf16, WS_PP)}; \
        pg8::gemm_phase<EpiBf16Plain, pg8::StaticOrder, true, true>(lds + RING_OFF, gp_, Sp_, Ep_, wave); } } while (0)
#define SSP(site) (WSP(float, WS_SSP) + (size_t)((site) % 3) * M * 16)
#define PH_LOCALS KArgs A = kargs(); const int G = opq_s(gridDim.x), bx = opq_s(blockIdx.x), wave = opq_s(wave_s), lane = lane_id(), tid = wave * 64 + lane; const int vcu = (G % 8 == 0) ? (bx % 8) * (G / 8) + bx / 8 : bx; const int gw = vcu * NWAVES + wave, NGW = G * NWAVES; (void)A; (void)lane; (void)gw; (void)NGW; (void)tid;
__global__ void __launch_bounds__(NWAVES * 64, 2) mk_fwd(Args args_unused) {
    extern __shared__ __attribute__((aligned(16))) unsigned char lds_raw[];
    LAS unsigned char* lds = (LAS unsigned char*)lds_raw;
    for (int u = threadIdx.x; u < (LDS_BYTES - LDSCTL_OFF) / 4; u += NWAVES * 64) ((LAS unsigned*)(lds + LDSCTL_OFF))[u] = 0u;
    __syncthreads();
    const int wave_s = __builtin_amdgcn_readfirstlane(threadIdx.x >> 6);
    int lo, hi;
    { KArgs A = kargs(); lo = A->ph_lo; hi = A->ph_hi;
#if !MK_MULTI
      (void)xcd_barrier_post(WSP(unsigned, WS_CTL) + CW_BAR, (volatile LAS unsigned*)(lds + MISC_OFF) + 8);
#endif
    }
    int ph = 0;
#define IN_PH (lo <= ph && ph < hi)
#if MK_MULTI
#define SEAM do { ++ph; } while (0)
#else
#define SEAM do { if (lo <= ph && ph + 1 < hi) { KArgs A_ = kargs(); XcdBarrier bar_; bar_.bar = (unsigned*)(A_->ws + WS_CTL) + CW_BAR; bar_.x = xb_xcc_id(); bar_.st = (volatile LAS unsigned*)(lds + MISC_OFF) + 8; xcd_barrier(bar_); } ++ph; } while (0)
#endif

    for (int rep = 0; rep < REP_PRO; ++rep) { if (rep) --ph;
    if (IN_PH) {
        PH_LOCALS
        bf16* HB = WSP(bf16, WS_HBX); float* SS = SSP(0); float* lbt = WSP(float, WS_TAB + TAB_LB);
        LAS float* scr = (LAS float*)(lds + RING_OFF + wave * 16384);
        convert_descs(A, 0, 10, gw, NGW, scr, lane);
        convert_descs(A, 20, 23, gw, NGW, scr, lane);
        convert_descs(A, 26, 35, gw, NGW, scr, lane);
        for (int it = gw; it < 8 * 16 * 8; it += NGW) { const int mat = it / 128, kb = (it % 128) / 8, nb = it % 8, i = mat >> 1, dd = mat & 1, k0 = 64 * kb, n = 32 * nb + (lane & 31);
            const float* wl = A->in[I_WIN] + (size_t)i * D * DIN + 1536 + 16 * dd; const float* g2 = A->in[I_WG2] + (size_t)(i * 2 + dd) * 16 * 256 + n; const float* nm = A->in[I_NMIX] + i * D;
            LAS float* wls = scr + 64 * 33;
            { const f32x4* wr4 = (const f32x4*)(wl + (size_t)(k0 + lane) * DIN); const f32x4 w0 = wr4[0], w1 = wr4[1], w2 = wr4[2], w3 = wr4[3]; const float sc = nm[k0 + lane];
              LAS f32x4* d4 = (LAS f32x4*)(wls + lane * 20); d4[0] = w0 * sc; d4[1] = w1 * sc; d4[2] = w2 * sc; d4[3] = w3 * sc; }
            float gr[16];
#pragma unroll
            for (int r = 0; r < 16; ++r) gr[r] = g2[r * 256];
            LDS_WAIT(); asm volatile("" ::: "memory");
#pragma unroll 4
            for (int q = 0; q < 32; ++q) { const int kk = 2 * q + (lane >> 5); const LAS f32x4* w4 = (const LAS f32x4*)(wls + kk * 20); const f32x4 a0 = w4[0], a1 = w4[1], a2 = w4[2], a3 = w4[3];
                float s = (a0[0] * gr[0] + a0[1] * gr[1]) + (a0[2] * gr[2] + a0[3] * gr[3]); s += (a1[0] * gr[4] + a1[1] * gr[5]) + (a1[2] * gr[6] + a1[3] * gr[7]);
                s += (a2[0] * gr[8] + a2[1] * gr[9]) + (a2[2] * gr[10] + a2[3] * gr[11]); s += (a3[0] * gr[12] + a3[1] * gr[13]) + (a3[2] * gr[14] + a3[3] * gr[15]);
                scr[kk * 33 + (lane & 31)] = s; }
            tr_writeout(WSP(bf16, WS_WIN) + (size_t)i * NPROJ * D, D, 4096 + 256 * dd + 32 * (4 * (nb & 1) + (nb >> 1)), k0, scr, lane);
        }
        for (int m0 = gw; m0 < M; m0 += 4 * NGW) { f32x4 xv[4][4];
#pragma unroll
            for (int r = 0; r < 4; ++r) { const int m = m0 + r * NGW; if (m < M) { const f32x4* xr = (const f32x4*)(A->in[I_X] + (size_t)m * D) + lane;
#pragma unroll
                for (int j = 0; j < 4; ++j) xv[r][j] = __builtin_nontemporal_load(xr + 64 * j); } }
#pragma unroll
            for (int r = 0; r < 4; ++r) { const int m = m0 + r * NGW; if (m < M) { v2u* br = (v2u*)(HB + (size_t)m * D) + lane; float s = 0.f;
#pragma unroll
                for (int j = 0; j < 4; ++j) { const f32x4 v = xv[r][j]; v2u w; w.x = pk2(v[0], v[1]); w.y = pk2(v[2], v[3]); br[64 * j] = w; const float r0 = bflo(w.x), r1 = bfhi(w.x), r2 = bflo(w.y), r3 = bfhi(w.y); s += (r0 * r0 + r1 * r1) + (r2 * r2 + r3 * r3); }
                s = wave_sum(s, lane); if (lane < 16) SS[(size_t)m * 16 + lane] = lane == 0 ? s : 0.f; } } }
        { const size_t n4 = (size_t)DEPTH * M * PLE / 4; const f32x4* src = (const f32x4*)A->in[I_P]; v2u* dst = WSP(v2u, WS_PB);
          const size_t st = (size_t)G * 512;
          for (size_t i0 = (size_t)bx * 512 + tid; i0 < n4; i0 += 8 * st) { f32x4 v[8];
#pragma unroll
              for (int j = 0; j < 8; ++j) if (i0 + j * st < n4) v[j] = __builtin_nontemporal_load(src + i0 + j * st);
#pragma unroll
              for (int j = 0; j < 8; ++j) if (i0 + j * st < n4) { v2u w; w.x = pk2(v[j][0], v[j][1]); w.y = pk2(v[j][2], v[j][3]); __builtin_nontemporal_store(w, dst + i0 + j * st); } } }
        for (int i = bx * 512 + tid; i < 1024; i += G * 512) { const float* l = A->in[I_LBL]; float z0 = l[i], z1 = l[1024 + i], z2 = l[2048 + i], z3 = l[3072 + i];
            const float mx = fmaxf(fmaxf(z0, z1), fmaxf(z2, z3)); z0 = __expf(z0 - mx); z1 = __expf(z1 - mx); z2 = __expf(z2 - mx); z3 = __expf(z3 - mx);
            const float inv = 1.0f / (z0 + z1 + z2 + z3);
            lbt[i] = 0.f; lbt[1024 + i] = z1 * inv; lbt[2048 + i] = (z1 + z2) * inv; lbt[3072 + i] = (z1 + z2 + z3) * inv; }
    }
    SEAM; }

    for (int layer = 0; layer < DEPTH; ++layer) {
        for (int rep = 0; rep < REP_G1; ++rep) { if (rep) --ph;
        if (IN_PH) {
            PH_LOCALS
            pg8::Gemm g{WSP(bf16, WS_HBX), WSP(bf16, WS_WIN) + (size_t)layer * NPROJ * D, D}; pg8::StaticOrder S; S.init(M, NPROJ, G, bx);
            fill_rs_table((LAS float*)(lds + RSTAB_OFF), S, SSP(layer * 3), nullptr, 1.0f, tid);
            EpiProj E{WSP(bf16, WS_BIG), (const LAS float*)(lds + RSTAB_OFF), WSP(float, WS_TAB + TAB_LB) + layer * 1024, A->in[I_BG] + layer * 512};
            pg8::gemm_phase<EpiProj, pg8::StaticOrder, true, true>(lds + RING_OFF, g, S, E, wave);
            if (rep == 0 && layer == 0) FILLER(S.nwg, 35, 40);
            if (rep == 0 && layer == 1) FILLER(S.nwg, 45, 50);
            if (rep == 0 && layer == 2) FILLER(S.nwg, 62, 66);
            if (rep == 0 && layer == 3) FILLER(S.nwg, 70, 74);
        }
        SEAM; }
        for (int rep = 0; rep < REP_SCAN; ++rep) { if (rep) ph -= 3;
        if (IN_PH) {
            PH_LOCALS
            for (int unit = bx; unit < 256; unit += G) scan::scan_pair<false>(unit, layer, lds, wave, lane);
        }
        SEAM;
        if (IN_PH) {
            PH_LOCALS
            const float* Db = WSP(float, WS_XG + scan::D_OFF);
            for (int gt = bx * 512 + tid; gt < 32768 + 65536; gt += G * 512) {
                const bool hg = gt >= 32768; const int r = hg ? gt - 32768 : gt, ndt = hg ? 8 : 4, ln = r & 63; int x = r >> 6; const int dt = x % ndt; x /= ndt; const int w = x & 7; x >>= 3; const int dir = x & 1, seq = x >> 1;
                f32x4* E = hg ? WSP(f32x4, WS_XG + scan::E_H_OFF) : WSP(f32x4, WS_XG + scan::E_G_OFF);
                f32x4 carry = (f32x4){0.f, 0.f, 0.f, 0.f};
                for (int i0 = 0; i0 < 32; i0 += 8) {
                    f32x4 e8[8], d8[8];
#pragma unroll
                    for (int j = 0; j < 8; ++j) { const int seg = dir ? 31 - (i0 + j) : (i0 + j); e8[j] = scan::unpack4(((const v2u*)E)[scan::e_index(seq * 32 + seg, dir, w, ndt, dt, ln)]); d8[j] = *(const f32x4*)(Db + scan::d_index(hg ? 1 : 0, seq, dir, seg, 16 * dt + 4 * (ln >> 4))); }
#pragma unroll
                    for (int j = 0; j < 8; ++j) { const int seg = dir ? 31 - (i0 + j) : (i0 + j); ((v2u*)E)[scan::e_index(seq * 32 + seg, dir, w, ndt, dt, ln)] = scan::pack4(carry[0], carry[1], carry[2], carry[3]); carry = d8[j] * carry + e8[j]; }
                }
            }
        }
        SEAM;
        if (IN_PH) {
            PH_LOCALS
            for (int unit = bx; unit < 256; unit += G) {
                scan::scan_unit<64, false, true>(WSP(bf16, WS_BIG), WSP(float, WS_YS), WSP(f32x4, WS_XG + scan::E_G_OFF), nullptr, WSP(bf16, WS_Y), A->in[I_GON] + layer * 128, unit, lds, wave, lane);
                scan::scan_unit<128, true, true>(WSP(bf16, WS_BIG), WSP(float, WS_YS), WSP(f32x4, WS_XG + scan::E_H_OFF), nullptr, WSP(bf16, WS_Y), A->in[I_HON] + layer * 128, unit, lds, wave, lane);
            }
        }
        SEAM; }
        if (IN_PH) {
            PH_LOCALS
            pg8::Gemm g{WSP(bf16, WS_Y), WSP(bf16, WS_WOUT) + (size_t)layer * D * D, D}; pg8::StaticOrder S; S.init(M, D, G, bx);
            EpiRes<0> E{WSP(bf16, WS_HBX), WSP(bf16, WS_HB), SSP(layer * 3 + 1), nullptr, nullptr, ((layer & 1) || F8_DENSE) ? WSP(unsigned char, WS_HQ) : nullptr, 1.0f};
            pg8::gemm_phase<EpiRes<0>, pg8::StaticOrder, true, true>(lds + RING_OFF, g, S, E, wave);
        }
        SEAM;
        if ((layer & 1) == 0) {
            for (int rep = 0; rep < REP_G3; ++rep) { if (rep) --ph;
            if (IN_PH) {
                PH_LOCALS
                #if F8_DENSE
                pg8::Gemm g{WSP(bf16, WS_HQ), (bf16*)(WSP(unsigned char, WS_WGU) + (size_t)(layer >> 1) * 2 * FFD * D), D / 2}; pg8::StaticOrder S; S.init(M, 2 * FFD, G, bx);
                fill_rs_table((LAS float*)(lds + RSTAB_OFF), S, SSP(layer * 3 + 1), nullptr, 1.0f / F8_GMUL, tid);
                EpiSwiGLU<true> E{WSP(bf16, WS_BIG), FFD, (const LAS float*)(lds + RSTAB_OFF)};
                pg8::gemm_phase<EpiSwiGLU<true>, pg8::StaticOrder, true, true, false, true>(lds + RING_OFF, g, S, E, wave);
#else
                pg8::Gemm g{WSP(bf16, WS_HB), WSP(bf16, WS_WGU) + (size_t)(layer >> 1) * 2 * FFD * D, D}; pg8::StaticOrder S; S.init(M, 2 * FFD, G, bx);
                fill_rs_table((LAS float*)(lds + RSTAB_OFF), S, SSP(layer * 3 + 1), nullptr, 1.0f, tid);
                EpiSwiGLU<(F8_DDN != 0)> E{WSP(bf16, WS_BIG), FFD, (const LAS float*)(lds + RSTAB_OFF)};
                pg8::gemm_phase<EpiSwiGLU<(F8_DDN != 0)>, pg8::StaticOrder, true, true>(lds + RING_OFF, g, S, E, wave);
#endif
                if (rep == 0 && layer == 0) FILLER(S.nwg, 40, 45);
                if (rep == 0 && layer >= 2) { PP_TAIL(S.nwg); FILLER(S.nwg, 66, 70); }
            }
            SEAM; }
            if (IN_PH) {
                PH_LOCALS
                #if F8_DENSE || F8_DDN
                pg8::Gemm g{WSP(bf16, WS_BIG), (bf16*)(WSP(unsigned char, WS_WDN) + (size_t)(layer >> 1) * D * FFD), FFD / 2}; pg8::StaticOrder S; S.init(M, D, G, bx);
                EpiRes<0> E{WSP(bf16, WS_HB), WSP(bf16, WS_HB), SSP(layer * 3 + 2), nullptr, nullptr, nullptr, 1.0f / (F8_WMUL * F8_AMUL)};
                pg8::gemm_phase<EpiRes<0>, pg8::StaticOrder, true, true, false, true>(lds + RING_OFF, g, S, E, wave);
#else
                pg8::Gemm g{WSP(bf16, WS_BIG), WSP(bf16, WS_WDN) + (size_t)(layer >> 1) * D * FFD, FFD}; pg8::StaticOrder S; S.init(M, D, G, bx);
                EpiRes<0> E{WSP(bf16, WS_HB), WSP(bf16, WS_HB), SSP(layer * 3 + 2), nullptr, nullptr, nullptr, 1.0f};
                pg8::gemm_phase<EpiRes<0>, pg8::StaticOrder, true, true>(lds + RING_OFF, g, S, E, wave);
#endif
            }
            SEAM;
            ph += 2;
        } else {
            if (IN_PH) {
                PH_LOCALS
                const bf16* hb = WSP(bf16, WS_HB); unsigned* cnt = WSP(unsigned, WS_CTL) + CW_CNT + (layer >> 1) * 8 * 64;
                int* ltok = WSP(int, WS_TAB + TAB_LTOK); float* lw = WSP(float, WS_TAB + TAB_LW); float* rstd_tok = WSP(float, WS_TAB + TAB_RSTD);
                LAS float* wrs = (LAS float*)lds;
                const float* wrt = A->in[I_WR] + (size_t)(layer >> 1) * D * NEXP; const float* nf = A->in[I_NFFN] + layer * D;
                for (int idx = tid; idx < D * NEXP; idx += 512) wrs[idx] = wrt[idx] * nf[idx >> 3];
                __syncthreads();
                for (int m0 = gw; m0 < M; m0 += 2 * NGW) {
                    f32x4 v[2][4]; float rs2[2]; float lg[2][8];
#pragma unroll
                    for (int t = 0; t < 2; ++t) { const int m = (m0 + t * NGW < M) ? m0 + t * NGW : m0; const char* hr = (const char*)hb + ((unsigned)m * (unsigned)(D * 2) + (unsigned)lane * 8u);
#pragma unroll
                        for (int q = 0; q < 4; ++q) { const v2u hw = *(const v2u*)(hr + 512 * q); v[t][q] = (f32x4){bflo(hw.x), bfhi(hw.x), bflo(hw.y), bfhi(hw.y)}; } }
#pragma unroll
                    for (int t = 0; t < 2; ++t) { float s = 0.f;
#pragma unroll
                        for (int q = 0; q < 4; ++q) s += (v[t][q][0] * v[t][q][0] + v[t][q][1] * v[t][q][1]) + (v[t][q][2] * v[t][q][2] + v[t][q][3] * v[t][q][3]);
                        rs2[t] = rsqrtf(wave_sum(s, lane) * (1.0f / 1024.0f) + EPS);
#pragma unroll
                        for (int e = 0; e < 8; ++e) lg[t][e] = 0.f; }
#pragma unroll
                    for (int q = 0; q < 4; ++q)
#pragma unroll
                        for (int c = 0; c < 4; ++c) { const int k = 256 * q + 4 * lane + c; const f32x4 w0 = *(const LAS f32x4*)(wrs + k * 8), w1 = *(const LAS f32x4*)(wrs + k * 8 + 4);
#pragma unroll
                            for (int t = 0; t < 2; ++t) { const float x = v[t][q][c];
                                lg[t][0] += x * w0[0]; lg[t][1] += x * w0[1]; lg[t][2] += x * w0[2]; lg[t][3] += x * w0[3]; lg[t][4] += x * w1[0]; lg[t][5] += x * w1[1]; lg[t][6] += x * w1[2]; lg[t][7] += x * w1[3]; } }
                    int i1[2], i2[2]; float p1[2], p2[2];
#pragma unroll
                    for (int t = 0; t < 2; ++t) { float mx = -1e30f;
#pragma unroll
                        for (int e = 0; e < 8; ++e) { lg[t][e] = wave_sum(lg[t][e], lane) * rs2[t]; mx = fmaxf(mx, lg[t][e]); }
                        float pe[8];
#pragma unroll
                        for (int e = 0; e < 8; ++e) pe[e] = __expf(lg[t][e] - mx);
                        i1[t] = 0; p1[t] = pe[0];
#pragma unroll
                        for (int e = 1; e < 8; ++e) if (pe[e] > p1[t]) { p1[t] = pe[e]; i1[t] = e; }
                        i2[t] = 0; p2[t] = -1.f;
#pragma unroll
                        for (int e = 0; e < 8; ++e) if (e != i1[t] && pe[e] > p2[t]) { p2[t] = pe[e]; i2[t] = e; } }
                    if (lane == 0) { unsigned qa[2] = {0u, 0u}, qb[2] = {0u, 0u};
#pragma unroll
                        for (int t = 0; t < 2; ++t) if (m0 + t * NGW < M) { qa[t] = __hip_atomic_fetch_add(cnt + 64 * i1[t], 1u, RLX_AGENT); qb[t] = __hip_atomic_fetch_add(cnt + 64 * i2[t], 1u, RLX_AGENT); }
#pragma unroll
                        for (int t = 0; t < 2; ++t) if (m0 + t * NGW < M) { const int m = m0 + t * NGW; const float w1 = p1[t] / (p1[t] + p2[t]), w2 = p2[t] / (p1[t] + p2[t]);
                            ltok[i1[t] * M + qa[t]] = m; lw[i1[t] * M + qa[t]] = w1; ltok[i2[t] * M + qb[t]] = m | (1 << 16); lw[i2[t] * M + qb[t]] = w2; rstd_tok[m] = rs2[t]; } }
                }
            }
            SEAM;
            for (int rep = 0; rep < REP_G5; ++rep) { if (rep) --ph;
            if (IN_PH) {
                PH_LOCALS
                #if F8_EGU
                pg8::Gemm g{WSP(bf16, WS_HQ), (bf16*)(WSP(unsigned char, WS_WEGU) + (size_t)(layer >> 1) * 8 * 2 * FFE * D), D / 2, WSP(int, WS_TAB + TAB_LTOK)};
#else
                pg8::Gemm g{WSP(bf16, WS_HB), WSP(bf16, WS_WEGU) + (size_t)(layer >> 1) * 8 * 2 * FFE * D, D, WSP(int, WS_TAB + TAB_LTOK)};
#endif
                pg8::GroupedOrder S; S.init(WSP(unsigned, WS_CTL) + CW_CNT + (layer >> 1) * 8 * 64, 2 * FFE / 256, G, bx, M);
                #if F8_EGU
                fill_rs_table((LAS float*)(lds + RSTAB_OFF), S, nullptr, WSP(float, WS_TAB + TAB_RSTD), 1.0f / F8_GMUL, tid, WSP(int, WS_TAB + TAB_LTOK));
                EpiSwiGLU<true> E{WSP(bf16, WS_BIG), FFE, (const LAS float*)(lds + RSTAB_OFF)};
                pg8::gemm_phase<EpiSwiGLU<true>, pg8::GroupedOrder, true, true, true, true>(lds + RING_OFF, g, S, E, wave);
#else
                fill_rs_table((LAS float*)(lds + RSTAB_OFF), S, nullptr, WSP(float, WS_TAB + TAB_RSTD), 1.0f, tid, WSP(int, WS_TAB + TAB_LTOK));
                EpiSwiGLU<true> E{WSP(bf16, WS_BIG), FFE, (const LAS float*)(lds + RSTAB_OFF)};
                pg8::gemm_phase<EpiSwiGLU<true>, pg8::GroupedOrder, true, true, true, false>(lds + RING_OFF, g, S, E, wave);
#endif
                if (rep == 0 && layer == 1) { FILLER(S.U, 10, 20); FILLER(S.U, 23, 26); }
                if (rep == 0 && layer >= 2) PP_TAIL(S.U);
            }
            SEAM; }
            if (IN_PH) {
                PH_LOCALS
                pg8::Gemm g{WSP(bf16, WS_BIG), (bf16*)(WSP(unsigned char, WS_WEDN) + (size_t)(layer >> 1) * 8 * D * FFE), FFE / 2}; pg8::GroupedOrder S; S.init(WSP(unsigned, WS_CTL) + CW_CNT + (layer >> 1) * 8 * 64, D / 256, G, bx, M);
                EpiScatter E{WSP(bf16, WS_YS), WSP(int, WS_TAB + TAB_LTOK), WSP(float, WS_TAB + TAB_LW)};
                pg8::gemm_phase<EpiScatter, pg8::GroupedOrder, true, true, false, true>(lds + RING_OFF, g, S, E, wave);
                if (layer == 1) FILLER(S.U, ND_PRO, 62);
            }
            SEAM;
            if (IN_PH) {
                PH_LOCALS
                const bf16* YS = WSP(bf16, WS_YS); bf16* HB = WSP(bf16, WS_HB); float* ss_ple = SSP(layer * 3 + 2);
                const char* Y0c = (const char*)YS; const char* Y1c = (const char*)(YS + (size_t)M * D); char* HBc = (char*)HB;
                for (int m0 = gw; m0 < M; m0 += 2 * NGW) { v2u hv[2][4], av[2][4], bv[2][4];
#pragma unroll
                    for (int r = 0; r < 2; ++r) { const int m = m0 + r * NGW < M ? m0 + r * NGW : m0; const unsigned ob = (unsigned)m * (unsigned)(D * 2) + (unsigned)lane * 8u;
#pragma unroll
                        for (int q = 0; q < 4; ++q) { hv[r][q] = *(const v2u*)(HBc + (ob + 512u * q)); av[r][q] = *(const v2u*)(Y0c + (ob + 512u * q)); bv[r][q] = *(const v2u*)(Y1c + (ob + 512u * q)); } }
#pragma unroll
                    for (int r = 0; r < 2; ++r) { const int m = m0 + r * NGW; if (m < M) { const unsigned ob = (unsigned)m * (unsigned)(D * 2) + (unsigned)lane * 8u; float s = 0.f;
#pragma unroll
                        for (int q = 0; q < 4; ++q) { const v2u hw = hv[r][q], a = av[r][q], b = bv[r][q];
                            v2u w; w.x = pg8::cvt_pk_bf16(bflo(hw.x) + (bflo(a.x) + bflo(b.x)), bfhi(hw.x) + (bfhi(a.x) + bfhi(b.x))); w.y = pg8::cvt_pk_bf16(bflo(hw.y) + (bflo(a.y) + bflo(b.y)), bfhi(hw.y) + (bfhi(a.y) + bfhi(b.y)));
                            *(v2u*)(HBc + (ob + 512u * q)) = w; const float r0 = bflo(w.x), r1 = bfhi(w.x), r2 = bflo(w.y), r3 = bfhi(w.y); s += (r0 * r0 + r1 * r1) + (r2 * r2 + r3 * r3); }
                        s = wave_sum(s, lane); if (lane < 16) ss_ple[(size_t)m * 16 + lane] = lane == 0 ? s : 0.f; } } }
            }
            SEAM;
        }
        if (IN_PH) {
            if (layer < 2) { PH_LOCALS
              pg8::Gemm g{WSP(bf16, WS_PB) + (size_t)layer * M * PLE, WSP(bf16, WS_WPP) + (size_t)layer * D * PLE, PLE}; pg8::StaticOrder S; S.init(M, D, G, bx);
              EpiBf16Plain E{WSP(bf16, WS_PP)};
              pg8::gemm_phase<EpiBf16Plain, pg8::StaticOrder, true, true>(lds + RING_OFF, g, S, E, wave); }
            VM_WAIT(); __syncthreads();
            { PH_LOCALS
              pg8::Gemm g{WSP(bf16, WS_HB), WSP(bf16, WS_WPG) + (size_t)layer * D * D, D}; pg8::StaticOrder S; S.init(M, D, G, bx);
              EpiRes<1> E{WSP(bf16, WS_HB), WSP(bf16, WS_HBX), SSP(layer * 3 + 3), SSP(layer * 3 + 2), WSP(bf16, WS_PP), nullptr, 1.0f};
              pg8::gemm_phase<EpiRes<1>, pg8::StaticOrder, true, true>(lds + RING_OFF, g, S, E, wave); }
        }
        SEAM;
    }
    if (IN_PH) {
        PH_LOCALS
        float* out = A->out; const bf16* hb = WSP(bf16, WS_HBX); const float* ssf = SSP(12); const f32x4* nw = (const f32x4*)A->in[I_NFIN] + lane;
        f32x4 wn[4];
#pragma unroll
        for (int q = 0; q < 4; ++q) wn[q] = nw[64 * q];
        for (int m0 = gw; m0 < M; m0 += 4 * NGW) { v2u hv[4][4]; float rs4[4];
#pragma unroll
            for (int r = 0; r < 4; ++r) { const int m = m0 + r * NGW; if (m < M) { const v2u* hr = (const v2u*)(hb + (size_t)m * D) + lane; rs4[r] = ss_load(ssf, m);
#pragma unroll
                for (int q = 0; q < 4; ++q) hv[r][q] = hr[64 * q]; } }
#pragma unroll
            for (int r = 0; r < 4; ++r) { const int m = m0 + r * NGW; if (m < M) { f32x4* orow = (f32x4*)(out + (size_t)m * D) + lane; const float rs = rsqrtf(rs4[r] * (1.0f / 1024.0f) + EPS);
#pragma unroll
                for (int q = 0; q < 4; ++q) { const v2u hw = hv[r][q]; __builtin_nontemporal_store((f32x4){bflo(hw.x), bfhi(hw.x), bflo(hw.y), bfhi(hw.y)} * rs * wn[q], orow + 64 * q); } } } }
    }
#undef IN_PH
#undef SEAM
}
constexpr int PH_PER_LAYER = 10, N_PHASES = 2 + DEPTH * PH_PER_LAYER;

extern "C" void kernel_launch(void* const* d_in, const int* in_sizes, int n_in, void* d_out, int out_size, void* d_ws, size_t ws_size, hipStream_t stream) {
    static int grid = 0;
    if (grid == 0) {
        if (n_in != 22 || out_size != M * D || ws_size < WS_END) { fprintf(stderr, "kernel_launch: unexpected shapes (n_in %d, out %d, ws %zu need %zu); nothing launched\n", n_in, out_size, ws_size, (size_t)WS_END); grid = -1; return; }
        int dev = 0, cus = 0;
        if (hipGetDevice(&dev) != hipSuccess || hipDeviceGetAttribute(&cus, hipDeviceAttributeMultiprocessorCount, dev) != hipSuccess) { grid = -1; return; }
        if (hipFuncSetAttribute((const void*)mk_fwd, hipFuncAttributeMaxDynamicSharedMemorySize, LDS_BYTES) != hipSuccess) { fprintf(stderr, "kernel_launch: hipFuncSetAttribute failed\n"); grid = -1; return; }
        int per_cu = 0;
        if (hipOccupancyMaxActiveBlocksPerMultiprocessor(&per_cu, (const void*)mk_fwd, NWAVES * 64, LDS_BYTES) != hipSuccess || per_cu < 1) fprintf(stderr, "kernel_launch: occupancy query says %d\n", per_cu);
        (void)hipGetLastError();
        grid = cus;
    }
    if (grid < 0) return;
    if (hipMemsetAsync((char*)d_ws + WS_CTL, 0, CTL_ZERO_BYTES, stream) != hipSuccess) return;
    Args a{};
    for (int i = 0; i < 22; ++i) a.in[i] = (const float*)d_in[i];
    a.out = (float*)d_out; a.ws = (unsigned char*)d_ws;
#if MK_MULTI
    for (int k = 0; k < N_PHASES; ++k) {
        if (k >= 1 && k < 1 + DEPTH * PH_PER_LAYER) { const int layer = (k - 1) / PH_PER_LAYER, p = (k - 1) % PH_PER_LAYER; if ((layer & 1) == 0 && p >= 7 && p <= 8) continue; }
        a.ph_lo = k; a.ph_hi = k + 1;
        hipLaunchKernelGGL(mk_fwd, dim3(grid), dim3(NWAVES * 64), LDS_BYTES, stream, a);
    }
#else
    a.ph_lo = 0; a.ph_hi = N_PHASES;
    hipLaunchKernelGGL(mk_fwd, dim3(grid), dim3(NWAVES * 64), LDS_BYTES, stream, a);
#endif
    const hipError_t le = hipPeekAtLastError();
    if (le != hipSuccess) fprintf(stderr, "kernel_launch: launch failed: %s\n", hipGetErrorName(le));
}
```
